# Optimizing an MI355X kernel written in HIP

```python
import jax, jax.numpy as jnp
from jax import lax
import numpy as np


D_MODEL = 1024
BATCH = 4
SEQ = 4096
DEPTH = 2

CONV_CH = D_MODEL
CONV_K = 31
SG_GROUPS = 8
SG_CH = D_MODEL
SG_DG = SG_CH // SG_GROUPS
CHUNK = 128
N_IN = 2 * CONV_CH + 2 * SG_CH + 2 * D_MODEL
FF_DENSE = 2816
N_EXPERTS = 8
TOP_K = 2
FF_EXPERT = 3584
N_DENSE = (DEPTH + 1) // 2
N_MOE = DEPTH // 2
EPS = 1e-6

kernel_name = "hybrid_conv_gmlp_gated_moe_block"


def rmsnorm(x, g):
    xf = x.astype(jnp.float32)
    y = xf * lax.rsqrt(jnp.mean(xf * xf, axis=-1, keepdims=True) + EPS)
    return (y * g.astype(jnp.float32)).astype(x.dtype)


def layernorm(x, g, b):
    xf = x.astype(jnp.float32)
    mu = jnp.mean(xf, axis=-1, keepdims=True)
    var = jnp.mean(jnp.square(xf - mu), axis=-1, keepdims=True)
    y = (xf - mu) * lax.rsqrt(var + EPS)
    return (y * g.astype(jnp.float32) + b.astype(jnp.float32)).astype(x.dtype)


def conv_branch(a_val, a_gate, conv_w, conv_b, ln_g, ln_b, w_out):
    a = a_val * jax.nn.sigmoid(a_gate)
    a = lax.conv_general_dilated(
        a, conv_w[:, None, :], window_strides=(1,),
        padding=[(CONV_K - 1, 0)],
        dimension_numbers=("NWC", "WIO", "NWC"),
        feature_group_count=CONV_CH) + conv_b
    a = jax.nn.silu(layernorm(a, ln_g, ln_b))
    return a @ w_out


def sgu_branch(u, v, ln_g, ln_b, w_s, b_s, w_out):
    bsz, seq, _ = u.shape
    u = jax.nn.gelu(u, approximate=False)
    v = jax.nn.gelu(v, approximate=False)
    v = v.reshape(bsz, seq // CHUNK, CHUNK, SG_GROUPS, SG_DG)
    v = layernorm(v, ln_g.reshape(SG_GROUPS, SG_DG), ln_b.reshape(SG_GROUPS, SG_DG))
    mask = jnp.tril(jnp.ones((CHUNK, CHUNK), dtype=bool))
    w = jnp.where(mask[None], w_s, jnp.zeros_like(w_s))
    v = jnp.einsum('gts,bnsgd->bntgd', w, v) + b_s.T[:, :, None]
    y = u * v.reshape(bsz, seq, SG_CH)
    return y @ w_out


def swiglu(h, w1, w3, w2):
    return (jax.nn.silu(h @ w1) * (h @ w3)) @ w2


def moe_ffn(h, router, w1, w3, w2):
    bsz, seq, d = h.shape
    t = h.reshape(bsz * seq, d)
    logits = t.astype(jnp.float32) @ router.astype(jnp.float32)
    top_vals, top_idx = lax.top_k(logits, TOP_K)
    top_w = jax.nn.softmax(top_vals, axis=-1)
    combine = jnp.sum(jax.nn.one_hot(top_idx, N_EXPERTS, dtype=jnp.float32)
                      * top_w[..., None], axis=1).astype(h.dtype)
    out = jnp.zeros_like(t)
    for e in range(N_EXPERTS):
        out = out + combine[:, e:e + 1] * swiglu(t, w1[e], w3[e], w2[e])
    return out.reshape(bsz, seq, d)


def setup_inputs(seed: int = 0) -> dict:
    key = jax.random.key(seed)
    ks = jax.random.split(key, 32)
    f32 = jnp.float32
    D = D_MODEL

    def nrm(k, shape, scale):
        return jax.random.normal(k, shape, f32) * scale

    def gain(k, shape):
        return 1.0 + 0.01 * jax.random.normal(k, shape, f32)

    return {
        "x": nrm(ks[0], (BATCH, SEQ, D), 1.0),
        "g_mix": gain(ks[1], (DEPTH, D)),
        "w_in": nrm(ks[2], (DEPTH, D, N_IN), D ** -0.5),
        "conv_w": nrm(ks[3], (DEPTH, CONV_K, CONV_CH), CONV_K ** -0.5),
        "conv_b": nrm(ks[4], (DEPTH, CONV_CH), 0.01),
        "conv_ln_g": gain(ks[5], (DEPTH, CONV_CH)),
        "conv_ln_b": nrm(ks[6], (DEPTH, CONV_CH), 0.01),
        "w_conv_out": nrm(ks[7], (DEPTH, CONV_CH, D), CONV_CH ** -0.5),
        "sg_ln_g": gain(ks[8], (DEPTH, SG_CH)),
        "sg_ln_b": nrm(ks[9], (DEPTH, SG_CH), 0.01),
        "sg_w": nrm(ks[10], (DEPTH, SG_GROUPS, CHUNK, CHUNK), CHUNK ** -0.5),
        "sg_b": gain(ks[11], (DEPTH, SG_GROUPS, CHUNK)),
        "w_sg_out": nrm(ks[12], (DEPTH, SG_CH, D), SG_CH ** -0.5),
        "w_o": nrm(ks[13], (DEPTH, D, D), D ** -0.5),
        "g_ffn": gain(ks[14], (DEPTH, D)),
        "ffn_w1": nrm(ks[15], (N_DENSE, D, FF_DENSE), D ** -0.5),
        "ffn_w3": nrm(ks[16], (N_DENSE, D, FF_DENSE), D ** -0.5),
        "ffn_w2": nrm(ks[17], (N_DENSE, FF_DENSE, D), FF_DENSE ** -0.5),
        "moe_router": nrm(ks[18], (N_MOE, D, N_EXPERTS), D ** -0.5),
        "moe_w1": nrm(ks[19], (N_MOE, N_EXPERTS, D, FF_EXPERT), D ** -0.5),
        "moe_w3": nrm(ks[20], (N_MOE, N_EXPERTS, D, FF_EXPERT), D ** -0.5),
        "moe_w2": nrm(ks[21], (N_MOE, N_EXPERTS, FF_EXPERT, D), FF_EXPERT ** -0.5),
        "g_final": gain(ks[22], (D,)),
    }


def reference(x, g_mix, w_in, conv_w, conv_b, conv_ln_g, conv_ln_b, w_conv_out,
              sg_ln_g, sg_ln_b, sg_w, sg_b, w_sg_out, w_o, g_ffn,
              ffn_w1, ffn_w3, ffn_w2, moe_router, moe_w1, moe_w3, moe_w2, g_final):
    o_ag = CONV_CH
    o_u = 2 * CONV_CH
    o_v = o_u + SG_CH
    o_ga = o_v + SG_CH
    o_gb = o_ga + D_MODEL
    for l in range(DEPTH):
        h = rmsnorm(x, g_mix[l])
        p = h @ w_in[l]
        ya = conv_branch(p[..., :o_ag], p[..., o_ag:o_u], conv_w[l], conv_b[l],
                         conv_ln_g[l], conv_ln_b[l], w_conv_out[l])
        yb = sgu_branch(p[..., o_u:o_v], p[..., o_v:o_ga], sg_ln_g[l], sg_ln_b[l],
                        sg_w[l], sg_b[l], w_sg_out[l])
        m = jax.nn.sigmoid(p[..., o_ga:o_gb]) * ya + jax.nn.sigmoid(p[..., o_gb:]) * yb
        x = x + m @ w_o[l]
        h = rmsnorm(x, g_ffn[l])
        j = l // 2
        if l % 2 == 0:
            x = x + swiglu(h, ffn_w1[j], ffn_w3[j], ffn_w2[j])
        else:
            x = x + moe_ffn(h, moe_router[j], moe_w1[j], moe_w3[j], moe_w2[j])
    return rmsnorm(x, g_final)
```

```cpp
#include <hip/hip_runtime.h>
#include <cstdio>
#include <cstdint>
#include <utility>

#define LAS __attribute__((address_space(3)))
typedef unsigned short bf16_t;
typedef short bf16x8 __attribute__((ext_vector_type(8)));
typedef short bf16x4 __attribute__((ext_vector_type(4)));
typedef float f32x4 __attribute__((ext_vector_type(4)));
typedef float f32x2 __attribute__((ext_vector_type(2)));
typedef unsigned u32x4 __attribute__((ext_vector_type(4)));
typedef unsigned u32x2 __attribute__((ext_vector_type(2)));
typedef int i32x4 __attribute__((ext_vector_type(4)));
typedef int i32x8 __attribute__((ext_vector_type(8)));

#ifndef MK_N_LAUNCHES
#define MK_N_LAUNCHES 1
#endif
#ifndef MIX_FUSED
#define MIX_FUSED 1
#endif
#ifndef FILL_DELEGATE
#define FILL_DELEGATE 1
#endif
#ifndef FLAT_BAR
#define FLAT_BAR 1
#endif
#ifndef FFN_DOWN_FP8
#define FFN_DOWN_FP8 1
#endif
#ifndef PH_MASK
#define PH_MASK 0x7fff
#endif
#define PH_MASK_ALL (PH_MASK == 0x7fff)

constexpr int T = 16384, D = 1024, SEQ = 4096, NIN = 6144, FFD = 2816, FFE = 3584, NE = 8, CK = 31, CHUNK = 128;
constexpr float EPS = 1e-6f;
constexpr float W13_SCALE = 32.0f, W2_SCALE = 64.0f;
constexpr int NPHASE = 15;

constexpr size_t MiB = 1u << 20;
constexpr size_t WS_CTL = 0, CTL_ZERO_BYTES = 65536;
constexpr size_t WS_WIN = 1 * MiB;
constexpr size_t WS_WCS = 25 * MiB;
constexpr size_t WS_WO = 33 * MiB;
constexpr size_t WS_WF13 = 37 * MiB;
constexpr size_t WS_WF2 = 48 * MiB;
constexpr size_t WS_SGW = 54 * MiB;
constexpr size_t WS_SSQ = 54 * MiB + 512 * 1024;
constexpr size_t WS_LIST = 55 * MiB;
constexpr size_t WS_CWT = 56 * MiB + 512 * 1024;
constexpr size_t WS_WM13 = 57 * MiB;
constexpr size_t WS_WM2 = 169 * MiB;
constexpr size_t WS_XB = 225 * MiB;
constexpr size_t WS_H = 257 * MiB;
constexpr size_t WS_END = 495 * MiB;
constexpr size_t PLANE = (size_t)T * D;
constexpr int CW_CNT = 64;
constexpr int CW_BAR = 4096;
constexpr int CW_FLAT = 2048;

constexpr int LDS_BYTES = 163840;
constexpr int MISC_OFF = 133632;
constexpr int M_TOK = 0;
constexpr int M_P = 1024;
constexpr int M_AUX = 5120;
constexpr int M_XB = 30176;
constexpr int M_PL = 13328;

__device__ __forceinline__ unsigned cvt_pk_bf16(float lo, float hi) { unsigned r; asm volatile("v_cvt_pk_bf16_f32 %0, %1, %2" : "=v"(r) : "v"(lo), "v"(hi)); return r; }
__device__ __forceinline__ float bf_lo(unsigned u) { return __uint_as_float(u << 16); }
__device__ __forceinline__ float bf_hi(unsigned u) { return __uint_as_float(u & 0xffff0000u); }
__device__ __forceinline__ float sigmoidf_(float x) { return __builtin_amdgcn_rcpf(1.0f + __builtin_amdgcn_exp2f(-1.44269504089f * x)); }
__device__ __forceinline__ float siluf_(float x) { return x * sigmoidf_(x); }
__device__ __forceinline__ float wave_sum(float v) {
#pragma unroll
    for (int o = 1; o < 64; o <<= 1) v += __shfl_xor(v, o);
    return v;
}
__device__ __forceinline__ f32x2 gelu_pk(f32x2 v) {
    const f32x2 av = __builtin_elementwise_abs(v), d = av * 0.2316418882f + 1.0f;
    f32x2 t; t.x = __builtin_amdgcn_rcpf(d.x); t.y = __builtin_amdgcn_rcpf(d.y);
    f32x2 q = t * 0.5307027145f + (-0.7265760135f); q = q * t + 0.7107068705f; q = q * t + (-0.142248368f); q = q * t + 0.127414796f; q = q * t;
    const f32x2 s = (v * v) * (-0.72134752044f);
    f32x2 e; e.x = __builtin_amdgcn_exp2f(s.x); e.y = __builtin_amdgcn_exp2f(s.y);
    return av * (0.5f - q * e) + v * 0.5f;
}
__device__ __forceinline__ f32x4 gelu4(f32x4 v) { const f32x2 a = gelu_pk((f32x2){v[0], v[1]}), b = gelu_pk((f32x2){v[2], v[3]}); return (f32x4){a.x, a.y, b.x, b.y}; }
__device__ __forceinline__ f32x4 swiglu4(f32x4 a, f32x4 b, float c, float k) { const f32x4 t = a * c; f32x4 e, r;
#pragma unroll
    for (int i = 0; i < 4; ++i) e[i] = __builtin_amdgcn_exp2f(t[i]);
    e = e + 1.0f;
#pragma unroll
    for (int i = 0; i < 4; ++i) r[i] = __builtin_amdgcn_rcpf(e[i]);
    return (a * b) * (r * k); }
__device__ __forceinline__ f32x4 glu4(f32x4 v, f32x4 g, float c, float rs) { const f32x4 t = g * c; f32x4 e, r;
#pragma unroll
    for (int i = 0; i < 4; ++i) e[i] = __builtin_amdgcn_exp2f(t[i]);
    e = e + 1.0f;
#pragma unroll
    for (int i = 0; i < 4; ++i) r[i] = __builtin_amdgcn_rcpf(e[i]);
    return v * (r * rs); }
__device__ __forceinline__ f32x4 sigm4(f32x4 v) { return (f32x4){sigmoidf_(v[0]), sigmoidf_(v[1]), sigmoidf_(v[2]), sigmoidf_(v[3])}; }
__device__ __forceinline__ u32x4 pack8(f32x4 a, f32x4 b) { u32x4 w; w.x = cvt_pk_bf16(a[0], a[1]); w.y = cvt_pk_bf16(a[2], a[3]); w.z = cvt_pk_bf16(b[0], b[1]); w.w = cvt_pk_bf16(b[2], b[3]); return w; }
__device__ __forceinline__ u32x2 pack8_fp8(f32x4 a, f32x4 b) { int w0 = 0, w1 = 0;
    w0 = __builtin_amdgcn_cvt_pk_fp8_f32(a[0], a[1], w0, false); w0 = __builtin_amdgcn_cvt_pk_fp8_f32(a[2], a[3], w0, true);
    w1 = __builtin_amdgcn_cvt_pk_fp8_f32(b[0], b[1], w1, false); w1 = __builtin_amdgcn_cvt_pk_fp8_f32(b[2], b[3], w1, true); return (u32x2){(unsigned)w0, (unsigned)w1}; }
__device__ __forceinline__ f32x4 unpk_lo(u32x4 w) { return (f32x4){bf_lo(w.x), bf_hi(w.x), bf_lo(w.y), bf_hi(w.y)}; }
__device__ __forceinline__ f32x4 unpk_hi(u32x4 w) { return (f32x4){bf_lo(w.z), bf_hi(w.z), bf_lo(w.w), bf_hi(w.w)}; }

namespace pg8 {
constexpr int BM = 256, BK = 64, HALF = 128, HTB = HALF * BK * 2, STAGE_BYTES = 8 * HTB, NXCD = 8, WGM = 8;
__host__ __device__ __forceinline__ int lds_byte(int r, int c) { const int st = (r >> 4) * 2 + (c >> 5), rr = r & 15, cc = c & 31, ob = rr * 64 + cc * 2; return st * 1024 + (ob ^ (((ob >> 9) & 1) << 5)); }
__host__ __device__ __forceinline__ void stage_rc(int b, int& R, int& C) { const int st = b / 1024, sb = b % 1024, swz = sb ^ (((sb >> 9) & 1) << 5); R = (st >> 1) * 16 + swz / 64; C = (st & 1) * 32 + (swz % 64) / 2; }
__host__ __device__ __forceinline__ int perm32(int rho) { const int n = rho >> 4, i = rho & 15; return 8 * (i >> 2) + 4 * n + (i & 3); }

struct Unit { int pm, pn, e, ti; };
struct StaticOrder {
    int nM, nN, nwg, G, c;
    __device__ __forceinline__ void init(int nM_, int nN_, int G_, int c_) { nM = nM_; nN = nN_; nwg = nM * nN; G = G_; c = c_; }
    __device__ __forceinline__ bool next(int i, Unit& u) const {
        const long L = (long)i * G + c; if (L >= nwg) return false;
        int wgid = (int)L; { const int q = nwg / NXCD, r = nwg % NXCD, xcd = wgid % NXCD, off = wgid / NXCD; wgid = (xcd < r ? xcd * (q + 1) : r * (q + 1) + (xcd - r) * q) + off; }
        const int nig = WGM * nN, gid = wgid / nig, fm = gid * WGM, gsz = (nM - fm) < WGM ? (nM - fm) : WGM;
        u.pm = fm + ((wgid % nig) % gsz); u.pn = (wgid % nig) / gsz; u.e = 0; u.ti = 0; return true;
    }
};

template <class Epi, class Sched, bool ALIGN_EPI>
__device__ __forceinline__ void gemm_phase(LAS unsigned char* lds, LAS unsigned char* misc, const Sched& S, const Epi& E) {
    constexpr bool GATHER = Sched::GATHER, FP8 = Sched::FP8;
    int tid_ = threadIdx.x; asm volatile("" : "+v"(tid_));
    const int tid = tid_, wid = __builtin_amdgcn_readfirstlane(tid >> 6), lane = tid & 63, wr = wid >> 2, wc = wid & 3, fr = lane & 15, fq = lane >> 4;
    const int K = S.K, nt = K / BK;
    unsigned voffA[2][2], voffB[2], colA2[2]; int rowA[2];
#pragma unroll
    for (int i = 0; i < 2; ++i) { int R, C; stage_rc(tid * 16 + i * 8192, R, C); const int Rb = (R & ~31) + perm32(R & 31);
        voffA[0][i] = voffA[1][i] = (unsigned)(R * K + C) * 2u; voffB[i] = (unsigned)(Rb * K + C) * 2u; rowA[i] = R; colA2[i] = (unsigned)C * 2u; }
    const size_t kstep = (size_t)(BK * 2);
    const size_t hstep = (size_t)HALF * K * 2;
    const size_t hstepA = GATHER ? (size_t)0 : hstep;
    const unsigned ldsw = (unsigned)wid * 1024u;
    const int aoff = FP8 ? lds_byte(wr * 64 + fr, (fq & 1) * 16) + (fq >> 1) * 1024 : lds_byte(wr * 64 + fr, fq * 8);
    const int boff = FP8 ? lds_byte(wc * 32 + fr, (fq & 1) * 16) + (fq >> 1) * 1024 : lds_byte(wc * 32 + fr, fq * 8);
    constexpr int KSTR = FP8 ? 16 : 1024;
#define PG8_SA(b, h) (((b) * 2 + (h)) * HTB)
#define PG8_SB(b, h) ((4 + (b) * 2 + (h)) * HTB)
#define PG8_STAGE(bufoff, gbase, voff) do { _Pragma("unroll") for (int _i = 0; _i < 2; ++_i) \
        __builtin_amdgcn_global_load_lds((const unsigned*)((const char*)(gbase) + (voff)[_i]), (LAS unsigned*)(lds + (bufoff) + ldsw + _i * 8192), 16, 0, 0); } while (0)
#define PG8_LDA(dst, b, h) do { _Pragma("unroll") for (int m = 0; m < 4; ++m) { const i32x4 f0_ = *(const LAS i32x4*)(lds + PG8_SA(b, h) + aoff + m * 2048), f1_ = *(const LAS i32x4*)(lds + PG8_SA(b, h) + aoff + m * 2048 + KSTR); dst[m] = __builtin_shufflevector(f0_, f1_, 0, 1, 2, 3, 4, 5, 6, 7); } } while (0)
#define PG8_LDB(dst, b, h) do { _Pragma("unroll") for (int n = 0; n < 2; ++n) { const i32x4 f0_ = *(const LAS i32x4*)(lds + PG8_SB(b, h) + boff + n * 2048), f1_ = *(const LAS i32x4*)(lds + PG8_SB(b, h) + boff + n * 2048 + KSTR); dst[n] = __builtin_shufflevector(f0_, f1_, 0, 1, 2, 3, 4, 5, 6, 7); } } while (0)
#define PG8_HALF(v, k) __builtin_bit_cast(bf16x8, __builtin_shufflevector(v, v, 4 * (k), 4 * (k) + 1, 4 * (k) + 2, 4 * (k) + 3))
#define PG8_MMA(ai, bj, At, Bt) do { __builtin_amdgcn_s_setprio(1); _Pragma("unroll") for (int m = 0; m < 4; ++m) _Pragma("unroll") for (int n = 0; n < 2; ++n) { \
        if constexpr (FP8) asm volatile("v_mfma_scale_f32_16x16x128_f8f6f4 %0, %1, %2, %0, %3, %3 op_sel_hi:[0,0,0]" : "+v"(acc[ai][bj][m][n]) : "v"(Bt[n]), "v"(At[m]), "v"(one_scale)); \
        else { acc[ai][bj][m][n] = __builtin_amdgcn_mfma_f32_16x16x32_bf16(PG8_HALF(Bt[n], 0), PG8_HALF(At[m], 0), acc[ai][bj][m][n], 0, 0, 0); \
               acc[ai][bj][m][n] = __builtin_amdgcn_mfma_f32_16x16x32_bf16(PG8_HALF(Bt[n], 1), PG8_HALF(At[m], 1), acc[ai][bj][m][n], 0, 0, 0); } } __builtin_amdgcn_s_setprio(0); } while (0)
#define PG8_WAIT_V(n) asm volatile("s_waitcnt vmcnt(" #n ")" ::: "memory")
#define PG8_WAIT_L(n) asm volatile("s_waitcnt lgkmcnt(" #n ")" ::: "memory")
#define PG8_BAR __builtin_amdgcn_s_barrier()
#define PG8_SCHED __builtin_amdgcn_sched_barrier(0)
    Unit cur, nxt; int ui = 0;
    if (!S.next(0, cur)) return;
    if constexpr (GATHER) {
#pragma unroll
        for (int h = 0; h < 2; ++h)
#pragma unroll
            for (int i = 0; i < 2; ++i) voffA[h][i] = (unsigned)S.tok(cur, h * HALF + rowA[i]) * (unsigned)(K * 2) + colA2[i];
    }
    f32x4 acc[2][2][4][2];
#pragma unroll
    for (int a = 0; a < 2; ++a)
#pragma unroll
        for (int b = 0; b < 2; ++b)
#pragma unroll
            for (int m = 0; m < 4; ++m)
#pragma unroll
                for (int n = 0; n < 2; ++n) acc[a][b][m][n] = (f32x4){0.f, 0.f, 0.f, 0.f};
    i32x8 At[4], B0[2], B1[2];
    const int one_scale = 0x7f7f7f7f;
    const char* cA = S.a_base(cur); const char* cB = S.b_base(cur);
    if (wid == 0) S.aux_dma(cur, 0, misc, lane);
    PG8_STAGE(PG8_SB(0, 0), cB, voffB); PG8_STAGE(PG8_SB(0, 1), cB + hstep, voffB); PG8_STAGE(PG8_SA(0, 0), cA, voffA[0]); PG8_STAGE(PG8_SA(0, 1), cA + hstepA, voffA[1]);
    if (wr == 1) PG8_BAR;
    PG8_WAIT_V(2); PG8_BAR;
    PG8_STAGE(PG8_SB(1, 0), cB + kstep, voffB); PG8_STAGE(PG8_SA(1, 0), cA + kstep, voffA[0]); PG8_STAGE(PG8_SB(1, 1), cB + hstep + kstep, voffB);
    PG8_WAIT_V(6); PG8_BAR;
    for (;;) {
        const bool has_next = S.next(ui + 1, nxt);
        const char* nA = has_next ? S.a_base(nxt) : cA; const char* nB = has_next ? S.b_base(nxt) : cB;
        unsigned nvoffA[2][2];
#pragma unroll
        for (int h = 0; h < 2; ++h)
#pragma unroll
            for (int i = 0; i < 2; ++i) nvoffA[h][i] = voffA[h][i];
        if constexpr (GATHER) {
            if (has_next && wid == 0) __builtin_amdgcn_global_load_lds((const unsigned*)(S.tok_ptr(nxt) + lane * 16), (LAS unsigned*)(misc + M_TOK), 16, 0, 0);
        }
        for (int t = 0; t < nt; t += 2) {
            const bool last = (t == nt - 2);
            if (t == 2 && has_next && wid == 0) S.aux_dma(nxt, ui + 1, misc, lane);
            const char* a1 = cA + (size_t)(t + 1) * kstep;
            const char* a2 = last ? nA : cA + (size_t)(t + 2) * kstep; const char* b2 = last ? nB : cB + (size_t)(t + 2) * kstep;
            const char* a3 = a2 + kstep; const char* b3 = b2 + kstep;
            unsigned va2[2][2];
            if constexpr (GATHER) {
                if (last && has_next) {
#pragma unroll
                    for (int h = 0; h < 2; ++h)
#pragma unroll
                        for (int i = 0; i < 2; ++i) { const unsigned tk = *(const LAS unsigned*)(misc + M_TOK + (h * HALF + rowA[i]) * 4); nvoffA[h][i] = ((tk >> 1) & (unsigned)(T - 1)) * (unsigned)(K * 2) + colA2[i]; }
                }
#pragma unroll
                for (int h = 0; h < 2; ++h)
#pragma unroll
                    for (int i = 0; i < 2; ++i) va2[h][i] = last ? nvoffA[h][i] : voffA[h][i];
            } else {
#pragma unroll
                for (int h = 0; h < 2; ++h)
#pragma unroll
                    for (int i = 0; i < 2; ++i) va2[h][i] = voffA[h][i];
            }
            PG8_LDB(B0, 0, 0); PG8_LDB(B1, 0, 1); PG8_SCHED; PG8_LDA(At, 0, 0); PG8_STAGE(PG8_SA(1, 1), a1 + hstepA, voffA[1]);
            PG8_WAIT_V(8); PG8_WAIT_L(0); PG8_BAR; PG8_MMA(0, 0, At, B0); PG8_MMA(0, 1, At, B1); PG8_BAR; PG8_SCHED;
            PG8_LDA(At, 0, 1); PG8_STAGE(PG8_SB(0, 0), b2, voffB); PG8_STAGE(PG8_SB(0, 1), b2 + hstep, voffB); PG8_STAGE(PG8_SA(0, 0), a2, va2[0]);
            PG8_WAIT_V(8); PG8_WAIT_L(0); PG8_BAR; PG8_MMA(1, 0, At, B0); PG8_MMA(1, 1, At, B1); PG8_BAR; PG8_SCHED;
            PG8_LDB(B0, 1, 0); PG8_LDB(B1, 1, 1); PG8_SCHED; PG8_LDA(At, 1, 0); PG8_STAGE(PG8_SA(0, 1), a2 + hstepA, va2[1]);
            PG8_WAIT_V(8); PG8_WAIT_L(0); PG8_BAR; PG8_MMA(0, 0, At, B0); PG8_MMA(0, 1, At, B1); PG8_BAR; PG8_SCHED;
            PG8_LDA(At, 1, 1); PG8_STAGE(PG8_SB(1, 0), b3, voffB); PG8_STAGE(PG8_SB(1, 1), b3 + hstep, voffB); PG8_STAGE(PG8_SA(1, 0), a3, va2[0]);
            PG8_WAIT_V(8); PG8_WAIT_L(0); PG8_BAR; PG8_MMA(1, 0, At, B0); PG8_MMA(1, 1, At, B1); PG8_BAR; PG8_SCHED;
        }
        if constexpr (FP8) asm volatile("s_nop 15\n\ts_nop 15" ::: "memory");
        if constexpr (ALIGN_EPI) { if (wr == 0) PG8_BAR; }
        E(acc, cur, wr, wc, fr, fq, misc, ui);
        if (!has_next) break;
        bool zero = true;
        if constexpr (Epi::KEEP_ACC) zero = !E.keep(cur);
        if (zero) {
#pragma unroll
        for (int a = 0; a < 2; ++a)
#pragma unroll
            for (int b = 0; b < 2; ++b)
#pragma unroll
                for (int m = 0; m < 4; ++m)
#pragma unroll
                    for (int n = 0; n < 2; ++n) acc[a][b][m][n] = (f32x4){0.f, 0.f, 0.f, 0.f};
        }
        cur = nxt; cA = nA; cB = nB; ++ui;
#pragma unroll
        for (int h = 0; h < 2; ++h)
#pragma unroll
            for (int i = 0; i < 2; ++i) voffA[h][i] = nvoffA[h][i];
        if constexpr (ALIGN_EPI) { if (wr == 1) PG8_BAR; }
    }
    PG8_WAIT_V(0);
    if constexpr (!ALIGN_EPI) { if (wr == 0) PG8_BAR; }
    PG8_BAR;
#undef PG8_SA
#undef PG8_SB
#undef PG8_STAGE
#undef PG8_LDA
#undef PG8_LDB
#undef PG8_HALF
#undef PG8_MMA
#undef PG8_WAIT_V
#undef PG8_WAIT_L
#undef PG8_BAR
#undef PG8_SCHED
}
}

template <bool F8_> struct PlainSchedT {
    static constexpr bool GATHER = false, FP8 = F8_;
    pg8::StaticOrder so; const char* A; const char* Bt; int K;
    __device__ __forceinline__ bool next(int i, pg8::Unit& u) const { return so.next(i, u); }
    __device__ __forceinline__ const char* a_base(const pg8::Unit& u) const { return A + (size_t)u.pm * 256 * K * 2; }
    __device__ __forceinline__ const char* b_base(const pg8::Unit& u) const { return Bt + (size_t)u.pn * 256 * K * 2; }
    __device__ __forceinline__ int tok(const pg8::Unit&, int) const { return 0; }
    __device__ __forceinline__ const char* tok_ptr(const pg8::Unit&) const { return nullptr; }
    __device__ __forceinline__ void aux_dma(const pg8::Unit&, int, LAS unsigned char*, int) const {}
};
typedef PlainSchedT<false> PlainSched;
struct PairSched {
    static constexpr bool GATHER = false, FP8 = false;
    pg8::StaticOrder so; const char* A; const char* Bt; int K;
    __device__ __forceinline__ bool next(int i, pg8::Unit& u) const { pg8::Unit b; if (!so.next(i >> 1, b)) return false; const int br = i & 1; u.pm = b.pm + 64 * br; u.pn = b.pn + 4 * br; u.e = 0; u.ti = 0; return true; }
    __device__ __forceinline__ const char* a_base(const pg8::Unit& u) const { return A + (size_t)u.pm * 256 * K * 2; }
    __device__ __forceinline__ const char* b_base(const pg8::Unit& u) const { return Bt + (size_t)u.pn * 256 * K * 2; }
    __device__ __forceinline__ int tok(const pg8::Unit&, int) const { return 0; }
    __device__ __forceinline__ const char* tok_ptr(const pg8::Unit&) const { return nullptr; }
    __device__ __forceinline__ void aux_dma(const pg8::Unit&, int, LAS unsigned char*, int) const {}
};
struct MoeTiles { int tstart[NE + 1]; int cnt[NE]; };
template <bool G_> struct MoeSched {
    static constexpr bool GATHER = G_, FP8 = true;
    pg8::StaticOrder so; const char* A; const char* Bt; int K; size_t bexp; MoeTiles mt; const int* rowtok;
    __device__ __forceinline__ bool next(int i, pg8::Unit& u) const { if (!so.next(i, u)) return false; int e = 0;
#pragma unroll
        for (int j = 1; j < NE; ++j) e += (u.pm >= mt.tstart[j]) ? 1 : 0;
        int ts = 0;
#pragma unroll
        for (int j = 1; j < NE; ++j) ts = (e == j) ? mt.tstart[j] : ts;
        u.e = e; u.ti = u.pm - ts; return true; }
    __device__ __forceinline__ const char* a_base(const pg8::Unit& u) const { return GATHER ? A : A + (size_t)u.pm * 256 * K * 2; }
    __device__ __forceinline__ const char* b_base(const pg8::Unit& u) const { return Bt + (size_t)u.e * bexp + (size_t)u.pn * 256 * K * 2; }
    __device__ __forceinline__ int tok(const pg8::Unit& u, int r) const { return (rowtok[u.e * 16384 + u.ti * 256 + r] >> 1) & (T - 1); }
    __device__ __forceinline__ const char* tok_ptr(const pg8::Unit& u) const { return (const char*)(rowtok + u.e * 16384 + u.ti * 256); }
    const float* aux0; const float* aux1;
    __device__ __forceinline__ void aux_dma(const pg8::Unit& u, int ui, LAS unsigned char* misc, int lane) const { const int lb = u.e * 16384 + u.ti * 256 + lane * 4; LAS unsigned char* t = misc + M_AUX + (ui & 1) * 2048;
        __builtin_amdgcn_global_load_lds((const unsigned*)(aux0 + lb), (LAS unsigned*)t, 16, 0, 0);
        if constexpr (!GATHER) __builtin_amdgcn_global_load_lds((const unsigned*)(aux1 + lb), (LAS unsigned*)(t + 1024), 16, 0, 0); }
};

__device__ __forceinline__ float row_rs(const float* ssq, int row) { return __builtin_amdgcn_rsqf((ssq[row] + ssq[T + row] + ssq[2 * T + row] + ssq[3 * T + row]) * (1.0f / D) + EPS); }

struct EpiA {   static constexpr bool KEEP_ACC = false;
    bf16_t* planes; const float* ssq;
    __device__ __forceinline__ void operator()(const f32x4 (&acc)[2][2][4][2], const pg8::Unit& u, int wr, int wc, int fr, int fq, LAS unsigned char* misc, int ui) const {
        const int row0 = u.pm * 256 + wr * 64 + fr; const LAS float* rst = (const LAS float*)(misc + M_AUX) + ui * 256 + wr * 64 + fr;
        if (u.pn < 8) {
            bf16_t* base = planes + (size_t)row0 * D + u.pn * 128 + wc * 32 + 8 * fq;
#pragma unroll
            for (int ai = 0; ai < 2; ++ai)
#pragma unroll
                for (int m = 0; m < 4; ++m) { const int r = ai * 128 + m * 16; const float rs = rst[r];
                    const float cc = rs * -1.44269504089f; const f32x4 o0 = glu4(acc[ai][0][m][0], acc[ai][1][m][0], cc, rs), o1 = glu4(acc[ai][0][m][1], acc[ai][1][m][1], cc, rs);
                    *(u32x4*)(base + (size_t)r * D) = pack8(o0, o1); }
        } else if (u.pn < 16) {
            const int p = (u.pn - 8) >> 2, colt = ((u.pn - 8) & 3) * 256;
            bf16_t* base = planes + (size_t)(1 + p) * PLANE + (size_t)row0 * D + colt + wc * 32 + 8 * fq;
#pragma unroll
            for (int ai = 0; ai < 2; ++ai)
#pragma unroll
                for (int m = 0; m < 4; ++m) { const int r = ai * 128 + m * 16; const float rs = rst[r];
#pragma unroll
                    for (int bj = 0; bj < 2; ++bj) *(u32x4*)(base + (size_t)r * D + bj * 128) = pack8(gelu4(acc[ai][bj][m][0] * rs), gelu4(acc[ai][bj][m][1] * rs)); }
        } else {
            bf16_t* base = planes + (size_t)3 * PLANE + (size_t)row0 * D + (u.pn - 16) * 128 + wc * 32 + 8 * fq;
#pragma unroll
            for (int ai = 0; ai < 2; ++ai)
#pragma unroll
                for (int m = 0; m < 4; ++m) { const int r = ai * 128 + m * 16; const float rs = rst[r] * -1.44269504089f; f32x4 rt[2], sb[2];
#pragma unroll
                    for (int n = 0; n < 2; ++n) { const f32x4 ga = acc[ai][0][m][n] * rs, gb = acc[ai][1][m][n] * rs;
                        f32x4 da, db, ra;
#pragma unroll
                        for (int i = 0; i < 4; ++i) { da[i] = __builtin_amdgcn_exp2f(ga[i]); db[i] = __builtin_amdgcn_exp2f(gb[i]); }
                        da = da + 1.0f; db = db + 1.0f;
#pragma unroll
                        for (int i = 0; i < 4; ++i) { ra[i] = __builtin_amdgcn_rcpf(da[i]); sb[n][i] = __builtin_amdgcn_rcpf(db[i]); }
                        rt[n] = db * ra; }
                    *(u32x4*)(base + (size_t)r * D) = pack8(rt[0], rt[1]); *(u32x4*)(base + PLANE + (size_t)r * D) = pack8(sb[0], sb[1]); }
        }
    }
};
struct EpiC {   static constexpr bool KEEP_ACC = true;
    bf16_t* mplane; const bf16_t* gates;
    __device__ __forceinline__ bool keep(const pg8::Unit& u) const { return (u.pn >> 2) == 0; }
    __device__ __forceinline__ void operator()(f32x4 (&acc)[2][2][4][2], const pg8::Unit& u, int wr, int wc, int fr, int fq, LAS unsigned char* misc, int ui) const {
        const int br = u.pn >> 2, pn = u.pn & 3, pm = u.pm - 64 * br;
        const size_t off0 = (size_t)(pm * 256 + wr * 64 + fr) * D + pn * 256 + wc * 32 + 8 * fq;
        const bf16_t* gp = gates + (size_t)br * PLANE + off0; bf16_t* mp = mplane + off0;
        u32x4 g[2][4][2];
#pragma unroll
        for (int ai = 0; ai < 2; ++ai)
#pragma unroll
            for (int m = 0; m < 4; ++m)
#pragma unroll
                for (int bj = 0; bj < 2; ++bj) g[ai][m][bj] = *(const u32x4*)(gp + (size_t)(ai * 128 + m * 16) * D + bj * 128);
#pragma unroll
        for (int ai = 0; ai < 2; ++ai)
#pragma unroll
            for (int m = 0; m < 4; ++m)
#pragma unroll
                for (int bj = 0; bj < 2; ++bj) { acc[ai][bj][m][0] *= unpk_lo(g[ai][m][bj]); acc[ai][bj][m][1] *= unpk_hi(g[ai][m][bj]); }
        if (br) {
#pragma unroll
            for (int ai = 0; ai < 2; ++ai)
#pragma unroll
                for (int m = 0; m < 4; ++m)
#pragma unroll
                    for (int bj = 0; bj < 2; ++bj) *(u32x4*)(mp + (size_t)(ai * 128 + m * 16) * D + bj * 128) = pack8(acc[ai][bj][m][0], acc[ai][bj][m][1]);
        }
    }
};
template <bool XF, bool ROUTE> struct EpiD {   static constexpr bool KEEP_ACC = false;
    const float* xf; bf16_t* xb; float* ssq; unsigned char* xq; float* plg; float scale;
    __device__ __forceinline__ void operator()(f32x4 (&acc)[2][2][4][2], const pg8::Unit& u, int wr, int wc, int fr, int fq, LAS unsigned char* misc, int ui) const {
        const size_t off0 = (size_t)(u.pm * 256 + wr * 64 + fr) * D + u.pn * 256 + wc * 32 + 8 * fq;
        LAS float* P = (LAS float*)(misc + M_P);
        if constexpr (XF) {
#pragma unroll
            for (int am = 0; am < 4; ++am) { const int ai = am >> 1, m0 = (am & 1) * 2; f32x4 xo[2][2][2];
#pragma unroll
                for (int m = 0; m < 2; ++m)
#pragma unroll
                    for (int bj = 0; bj < 2; ++bj) { const float* p = xf + off0 + (size_t)(ai * 128 + (m0 + m) * 16) * D + bj * 128; xo[m][bj][0] = *(const f32x4*)p; xo[m][bj][1] = *(const f32x4*)(p + 4); }
#pragma unroll
                for (int m = 0; m < 2; ++m)
#pragma unroll
                    for (int bj = 0; bj < 2; ++bj) { acc[ai][bj][m0 + m][0] = xo[m][bj][0] + acc[ai][bj][m0 + m][0] * scale; acc[ai][bj][m0 + m][1] = xo[m][bj][1] + acc[ai][bj][m0 + m][1] * scale;
                        asm volatile("" : "+v"(acc[ai][bj][m0 + m][0]), "+v"(acc[ai][bj][m0 + m][1]) :: "memory"); } }
        } else {
#pragma unroll
            for (int ai = 0; ai < 2; ++ai) { u32x4 xo[4][2];
#pragma unroll
                for (int m = 0; m < 4; ++m)
#pragma unroll
                    for (int bj = 0; bj < 2; ++bj) xo[m][bj] = *(const u32x4*)(xb + off0 + (size_t)(ai * 128 + m * 16) * D + bj * 128);
#pragma unroll
                for (int m = 0; m < 4; ++m)
#pragma unroll
                    for (int bj = 0; bj < 2; ++bj) { acc[ai][bj][m][0] = unpk_lo(xo[m][bj]) + acc[ai][bj][m][0] * scale; acc[ai][bj][m][1] = unpk_hi(xo[m][bj]) + acc[ai][bj][m][1] * scale;
                        asm volatile("" : "+v"(acc[ai][bj][m][0]), "+v"(acc[ai][bj][m][1]) :: "memory"); } }
        }
#pragma unroll
        for (int ai = 0; ai < 2; ++ai)
#pragma unroll
            for (int m = 0; m < 4; ++m) { float sq = 0.f;
#pragma unroll
                for (int bj = 0; bj < 2; ++bj) { const size_t o = off0 + (size_t)(ai * 128 + m * 16) * D + bj * 128;
                    const f32x4 v0 = acc[ai][bj][m][0], v1 = acc[ai][bj][m][1];
                    *(u32x4*)(xb + o) = pack8(v0, v1); if constexpr (ROUTE) *(u32x2*)(xq + o) = pack8_fp8(v0, v1);
                    sq += (v0[0] * v0[0] + v0[1] * v0[1]) + (v0[2] * v0[2] + v0[3] * v0[3]) + (v1[0] * v1[0] + v1[1] * v1[1]) + (v1[2] * v1[2] + v1[3] * v1[3]); }
                sq += __shfl_xor(sq, 16); sq += __shfl_xor(sq, 32);
                if (fq == 0) P[(ai * 128 + wr * 64 + m * 16 + fr) * 4 + wc] = sq; }
        asm volatile("s_waitcnt lgkmcnt(0)" ::: "memory"); __builtin_amdgcn_s_barrier(); asm volatile("" ::: "memory");
        const int tid = threadIdx.x;
        if (tid < 256) { const f32x4 p = *(const LAS f32x4*)(P + tid * 4); ssq[(size_t)u.pn * T + u.pm * 256 + tid] = (p[0] + p[1]) + (p[2] + p[3]); }
        asm volatile("s_waitcnt lgkmcnt(0)" ::: "memory"); __builtin_amdgcn_s_barrier(); asm volatile("" ::: "memory");
        if constexpr (ROUTE) {
            const LAS float* RW = (const LAS float*)(misc + M_AUX); LAS float* PL = (LAS float*)(misc + M_PL);
            const int cl = wc * 32 + 8 * fq;
#pragma unroll
            for (int hf = 0; hf < 2; ++hf) {
#pragma unroll
                for (int e4 = 0; e4 < 4; ++e4) { const int e = hf * 4 + e4; f32x4 w[2][2];
#pragma unroll
                    for (int bj = 0; bj < 2; ++bj) { w[bj][0] = *(const LAS f32x4*)(RW + e * 256 + bj * 128 + cl); w[bj][1] = *(const LAS f32x4*)(RW + e * 256 + bj * 128 + cl + 4); }
#pragma unroll
                    for (int ai = 0; ai < 2; ++ai)
#pragma unroll
                        for (int m = 0; m < 4; ++m) { f32x4 t = acc[ai][0][m][0] * w[0][0] + acc[ai][0][m][1] * w[0][1] + acc[ai][1][m][0] * w[1][0] + acc[ai][1][m][1] * w[1][1];
                            float d = (t[0] + t[1]) + (t[2] + t[3]); d += __shfl_xor(d, 16); d += __shfl_xor(d, 32);
                            if (fq == 0) PL[((ai * 128 + wr * 64 + m * 16 + fr) * 4 + wc) * 4 + e4] = d; } }
                asm volatile("s_waitcnt lgkmcnt(0)" ::: "memory"); __builtin_amdgcn_s_barrier(); asm volatile("" ::: "memory");
                if (tid < 256) { const LAS f32x4* q = (const LAS f32x4*)(PL + tid * 16); const f32x4 sum = (q[0] + q[1]) + (q[2] + q[3]);
                    *(f32x4*)(plg + ((size_t)u.pn * T + u.pm * 256 + tid) * 8 + hf * 4) = sum; }
                asm volatile("s_waitcnt lgkmcnt(0)" ::: "memory"); __builtin_amdgcn_s_barrier(); asm volatile("" ::: "memory");
            }
        }
    }
};
struct EpiE {   static constexpr bool KEEP_ACC = false;
    bf16_t* hid; const float* ssq; int ldh; int f8;
    __device__ __forceinline__ void operator()(const f32x4 (&acc)[2][2][4][2], const pg8::Unit& u, int wr, int wc, int fr, int fq, LAS unsigned char* misc, int ui) const {
        const int row0 = u.pm * 256 + wr * 64 + fr; const LAS float* rst = (const LAS float*)(misc + M_AUX) + ui * 256 + wr * 64 + fr;
        bf16_t* base = hid + (size_t)row0 * ldh + u.pn * 128 + wc * 32 + 8 * fq;
#pragma unroll
        for (int ai = 0; ai < 2; ++ai)
#pragma unroll
            for (int m = 0; m < 4; ++m) { const int r = ai * 128 + m * 16; const float rs = rst[r];
                f32x4 o[2];
#pragma unroll
                for (int n = 0; n < 2; ++n) o[n] = swiglu4(acc[ai][0][m][n], acc[ai][1][m][n], rs * -1.44269504089f, rs * rs);
                if (f8) *(u32x2*)((unsigned char*)hid + (size_t)(row0 + r) * ldh + u.pn * 128 + wc * 32 + 8 * fq) = pack8_fp8(o[0], o[1]); else *(u32x4*)(base + (size_t)r * ldh) = pack8(o[0], o[1]); }
    }
};
struct EpiG {   static constexpr bool KEEP_ACC = false;
    bf16_t* hid; const float* rowrs;
    __device__ __forceinline__ void operator()(const f32x4 (&acc)[2][2][4][2], const pg8::Unit& u, int wr, int wc, int fr, int fq, LAS unsigned char* misc, int ui) const {
        const int rl0 = wr * 64 + fr;
        unsigned char* base = (unsigned char*)hid + (size_t)(u.pm * 256 + rl0) * FFE + u.pn * 128 + wc * 32 + 8 * fq;
        const LAS float* rsp = (const LAS float*)(misc + M_AUX + (ui & 1) * 2048) + rl0;
#pragma unroll
        for (int ai = 0; ai < 2; ++ai)
#pragma unroll
            for (int m = 0; m < 4; ++m) { const int r = ai * 128 + m * 16; const float rs = rsp[r] * (1.0f / W13_SCALE);
                f32x4 o[2];
#pragma unroll
                for (int n = 0; n < 2; ++n) o[n] = swiglu4(acc[ai][0][m][n], acc[ai][1][m][n], rs * -1.44269504089f, rs * rs);
                *(u32x2*)(base + (size_t)r * FFE) = pack8_fp8(o[0], o[1]); }
    }
};
struct EpiH {   static constexpr bool KEEP_ACC = false;
    bf16_t* slots; const int* rowtok; const float* rowgate; MoeTiles mt;
    __device__ __forceinline__ void operator()(const f32x4 (&acc)[2][2][4][2], const pg8::Unit& u, int wr, int wc, int fr, int fq, LAS unsigned char* misc, int ui) const {
        int cnt = 0;
#pragma unroll
        for (int j = 0; j < NE; ++j) cnt = (u.e == j) ? mt.cnt[j] : cnt;
        const int nvalid = cnt - u.ti * 256, rl0 = wr * 64 + fr, col = u.pn * 256 + wc * 32 + 8 * fq;
        const LAS int* tst = (const LAS int*)(misc + M_AUX + (ui & 1) * 2048) + rl0; const LAS float* tgt = (const LAS float*)(misc + M_AUX + (ui & 1) * 2048 + 1024) + rl0;
#pragma unroll
        for (int ai = 0; ai < 2; ++ai)
#pragma unroll
            for (int m = 0; m < 4; ++m) { const int r = ai * 128 + m * 16;
                if (rl0 + r < nvalid) { const int ts = tst[r] & (2 * T - 1); const float g = tgt[r] * (1.0f / W2_SCALE);
                    bf16_t* o = slots + (size_t)ts * D + col;
#pragma unroll
                    for (int bj = 0; bj < 2; ++bj) *(u32x4*)(o + bj * 128) = pack8(acc[ai][bj][m][0] * g, acc[ai][bj][m][1] * g); } }
    }
};

template <class Sched> __device__ __forceinline__ void build_rs_table(const Sched& S, LAS unsigned char* misc, const float* ssq, int tid) {
    const int nu = (S.so.nwg - S.so.c + S.so.G - 1) / S.so.G;
    if (tid < 256 && nu > 0) { float q[6][4];
#pragma unroll
        for (int i = 0; i < 6; ++i) { pg8::Unit u; S.next(i < nu ? i : nu - 1, u); const float* p = ssq + u.pm * 256 + tid;
#pragma unroll
            for (int j = 0; j < 4; ++j) q[i][j] = p[j * T]; }
#pragma unroll
        for (int i = 0; i < 6; ++i) if (i < nu) ((LAS float*)(misc + M_AUX))[i * 256 + tid] = __builtin_amdgcn_rsqf(((q[i][0] + q[i][1]) + (q[i][2] + q[i][3])) * (1.0f / D) + EPS); }
    __syncthreads();
}

#define XB_TMO      128
#define XB_XCNT(j)  (256  + 64 * (j))
#define XB_XSUB(j)  (1280 + 64 * (j))
#define XB_XGEN(j)  (2304 + 64 * (j))
#define XB_TOP      3328
#define XB_TOPGEN   3392
#define XCD_BAR_WORDS 3456
#define XB_SPIN_CAP (1u << 18)
__device__ __forceinline__ unsigned xb_ld(unsigned* p)              { return __hip_atomic_load(p, __ATOMIC_RELAXED, __HIP_MEMORY_SCOPE_AGENT); }
__device__ __forceinline__ unsigned xb_add(unsigned* p, unsigned v) { return __hip_atomic_fetch_add(p, v, __ATOMIC_RELAXED, __HIP_MEMORY_SCOPE_AGENT); }
__device__ __forceinline__ unsigned xb_xcc_id() { return (unsigned)__builtin_amdgcn_s_getreg((3 << 11) | 20) & 0xFu; }
#define XB_SPIN(cond, bar) do { unsigned _sp = 0; while (cond) { __builtin_amdgcn_s_sleep(1); \
    if ((++_sp & 255u) == 0u) { if (xb_ld(&(bar)[XB_TMO])) break; if (_sp > XB_SPIN_CAP) { atomicAdd(&(bar)[XB_TMO], 1u); break; } } } } while (0)
struct XcdBarrier { unsigned* bar; unsigned x; volatile LAS unsigned* st; };
__device__ __forceinline__ XcdBarrier xcd_barrier_post(unsigned* bar, volatile LAS unsigned* st) {
    XcdBarrier b; b.bar = bar; b.x = xb_xcc_id(); b.st = st;
    if (threadIdx.x == 0) (void)xb_add(&bar[XB_XCNT(b.x)], 1u);
    return b;
}
__device__ __forceinline__ void xcd_barrier_complete(unsigned* bar, unsigned x, unsigned& nloc, unsigned& nx) {
    const unsigned G = gridDim.x * gridDim.y * gridDim.z;
    unsigned sum, cnt, mine, sp = 0u;
    for (;;) {
        sum = 0u; cnt = 0u; mine = 0u;
#pragma unroll
        for (unsigned j = 0; j < 16; ++j) { const unsigned c = xb_ld(&bar[XB_XCNT(j)]); sum += c; cnt += (c > 0u) ? 1u : 0u; mine = (j == x) ? c : mine; }
        if (sum == G) break;
        __builtin_amdgcn_s_sleep(1);
        if ((++sp & 255u) == 0u) { if (xb_ld(&bar[XB_TMO])) break; if (sp > XB_SPIN_CAP) { atomicAdd(&bar[XB_TMO], 1u); break; } }
    }
    nloc = mine > 0u ? mine : 1u; nx = cnt > 0u ? cnt : 1u;
}
__device__ __forceinline__ void xcd_barrier(const XcdBarrier& b) {
    asm volatile("s_waitcnt vmcnt(0)" ::: "memory");
    __syncthreads();
    if (threadIdx.x == 0) {
        unsigned* bar = b.bar;
        __builtin_amdgcn_s_waitcnt(0);
        unsigned nloc = b.st[0], nx = b.st[1];
        if (nloc == 0u) { xcd_barrier_complete(bar, b.x, nloc, nx); b.st[0] = nloc; b.st[1] = nx; }
        const unsigned old = xb_add(&bar[XB_XSUB(b.x)], 1u);
        const unsigned gen = old / nloc;
        if (old + 1u == (gen + 1u) * nloc) {
            __builtin_amdgcn_fence(__ATOMIC_RELEASE, "agent");
            asm volatile("s_waitcnt vmcnt(0)" ::: "memory");
            const unsigned og = xb_add(&bar[XB_TOP], 1u);
            const unsigned tg = og / nx;
            if (og + 1u == (tg + 1u) * nx) xb_add(&bar[XB_TOPGEN], 1u);
            else XB_SPIN(xb_ld(&bar[XB_TOPGEN]) == tg, bar);
            __builtin_amdgcn_fence(__ATOMIC_ACQUIRE, "agent");
            xb_add(&bar[XB_XGEN(b.x)], 1u);
            asm volatile("s_waitcnt vmcnt(0)" ::: "memory");
        } else {
            XB_SPIN(xb_ld(&bar[XB_XGEN(b.x)]) == gen, bar);
            __builtin_amdgcn_fence(__ATOMIC_ACQUIRE, "agent");
            asm volatile("s_waitcnt vmcnt(0)" ::: "memory");
        }
    }
    __syncthreads();
}

__device__ __forceinline__ void flat_barrier(unsigned* ctl, int base, int c, unsigned G) {
    asm volatile("s_waitcnt vmcnt(0)" ::: "memory");
    __syncthreads();
    if (threadIdx.x == 0) {
        __builtin_amdgcn_fence(__ATOMIC_RELEASE, "agent"); asm volatile("s_waitcnt vmcnt(0)" ::: "memory");
        (void)xb_add(&ctl[base + 16 * (c & 7)], 1u);
        unsigned sp = 0;
        for (;;) { unsigned sum = 0;
#pragma unroll
            for (int j = 0; j < 8; ++j) sum += xb_ld(&ctl[base + 16 * j]);
            if (sum >= G) break;
            __builtin_amdgcn_s_sleep(1);
            if ((++sp & 255u) == 0u) { if (xb_ld(&ctl[CW_BAR + XB_TMO])) break; if (sp > XB_SPIN_CAP) { atomicAdd(&ctl[CW_BAR + XB_TMO], 1u); break; } } }
        __builtin_amdgcn_fence(__ATOMIC_ACQUIRE, "agent"); asm volatile("s_waitcnt vmcnt(0)" ::: "memory"); }
    __syncthreads();
}

__device__ __forceinline__ void xpose_item(const float* W, int ldw, const float* g, bf16_t* WT, int Kd, int kb, int nb, int blk, int off, LAS float* scr, int lane) {
    const int k0 = 64 * kb, n0 = 64 * nb;
    const float* src = W + (size_t)k0 * ldw + n0 + lane;
    float v[64];
#pragma unroll
    for (int i = 0; i < 64; ++i) v[i] = __builtin_nontemporal_load(src + (size_t)i * ldw);
    if (g) {
#pragma unroll
        for (int i = 0; i < 64; ++i) scr[i * 65 + lane] = v[i] * g[k0 + i];
    } else {
#pragma unroll
        for (int i = 0; i < 64; ++i) scr[i * 65 + lane] = v[i];
    }
    asm volatile("s_waitcnt lgkmcnt(0)" ::: "memory");
    const int c = lane & 7;
#pragma unroll
    for (int j = 0; j < 8; ++j) { const int n = (lane >> 3) + 8 * j, nn = n0 + n; const LAS float* s = scr + (8 * c) * 65 + n;
        u32x4 o; o.x = cvt_pk_bf16(s[0 * 65], s[1 * 65]); o.y = cvt_pk_bf16(s[2 * 65], s[3 * 65]); o.z = cvt_pk_bf16(s[4 * 65], s[5 * 65]); o.w = cvt_pk_bf16(s[6 * 65], s[7 * 65]);
        *(u32x4*)(WT + (size_t)((nn >> 7) * blk + (nn & 127) + off) * Kd + k0 + 8 * c) = o; }
    asm volatile("s_waitcnt lgkmcnt(0)" ::: "memory");
}

__device__ __forceinline__ void xpose_item_fp8(const float* W, int ldw, const float* g, float sc, unsigned char* WT, int Kd, int kb, int nb, int blk, int off, LAS float* scr, int lane) {
    const int k0 = 64 * kb, n0 = 64 * nb;
    const float* src = W + (size_t)k0 * ldw + n0 + lane;
    float v[64];
#pragma unroll
    for (int i = 0; i < 64; ++i) v[i] = __builtin_nontemporal_load(src + (size_t)i * ldw);
    if (g) {
#pragma unroll
        for (int i = 0; i < 64; ++i) scr[i * 65 + lane] = v[i] * (g[k0 + i] * sc);
    } else {
#pragma unroll
        for (int i = 0; i < 64; ++i) scr[i * 65 + lane] = v[i] * sc;
    }
    asm volatile("s_waitcnt lgkmcnt(0)" ::: "memory");
    const int c = lane & 7;
#pragma unroll
    for (int j = 0; j < 8; ++j) { const int n = (lane >> 3) + 8 * j, nn = n0 + n; const LAS float* s = scr + (8 * c) * 65 + n;
        *(u32x2*)(WT + (size_t)((nn >> 7) * blk + (nn & 127) + off) * Kd + k0 + 8 * c) = pack8_fp8((f32x4){s[0 * 65], s[1 * 65], s[2 * 65], s[3 * 65]}, (f32x4){s[4 * 65], s[5 * 65], s[6 * 65], s[7 * 65]}); }
    asm volatile("s_waitcnt lgkmcnt(0)" ::: "memory");
}

struct Args { const float* in[23]; float* out; unsigned char* ws; int ph_lo, ph_hi; };
#define CAS __attribute__((address_space(4)))
typedef const CAS Args* ArgP;
__device__ __forceinline__ ArgP fresh_args() { unsigned long long p = (unsigned long long)__builtin_amdgcn_kernarg_segment_ptr(); asm volatile("" : "+s"(p)); return (ArgP)p; }
enum { I_X = 0, I_GMIX, I_WIN, I_CONVW, I_CONVB, I_CLNG, I_CLNB, I_WCO, I_SLNG, I_SLNB, I_SGW, I_SGB, I_WSO, I_WO, I_GFFN, I_F1, I_F3, I_F2, I_ROUTER, I_M1, I_M3, I_M2, I_GFINAL };


constexpr int IT_LAYER = 2304, IT_FFN = 2112, IT_EXP = 2688, IT_TOTAL = 2 * IT_LAYER + IT_FFN + NE * IT_EXP;
__device__ __forceinline__ void convert_item(ArgP ap, unsigned char* ws, int it, LAS float* scr, int lane) {
    int r = it;
    if (r < 2 * IT_LAYER) { const int l = r / IT_LAYER; r -= l * IT_LAYER;
        const float* win = ap->in[I_WIN] + (size_t)l * D * NIN; const float* gm = ap->in[I_GMIX] + l * D;
        bf16_t* wint = (bf16_t*)(ws + WS_WIN) + (size_t)l * NIN * D; bf16_t* wcs = (bf16_t*)(ws + WS_WCS) + (size_t)l * 2048 * D; bf16_t* wot = (bf16_t*)(ws + WS_WO) + (size_t)l * D * D;
        if (r < 256) { xpose_item(win, NIN, gm, wint, D, r >> 4, r & 15, 256, 0, scr, lane); return; } r -= 256;
        if (r < 256) { xpose_item(win + 1024, NIN, gm, wint, D, r >> 4, r & 15, 256, 128, scr, lane); return; } r -= 256;
        if (r < 512) { xpose_item(win + 2048, NIN, gm, wint, D, r >> 5, r & 31, 128, 2048, scr, lane); return; } r -= 512;
        if (r < 256) { xpose_item(win + 4096, NIN, gm, wint, D, r >> 4, r & 15, 256, 4096, scr, lane); return; } r -= 256;
        if (r < 256) { xpose_item(win + 5120, NIN, gm, wint, D, r >> 4, r & 15, 256, 4096 + 128, scr, lane); return; } r -= 256;
        if (r < 256) { xpose_item(ap->in[I_WCO] + (size_t)l * D * D, D, nullptr, wcs, D, r >> 4, r & 15, 128, 0, scr, lane); return; } r -= 256;
        if (r < 256) { xpose_item(ap->in[I_WSO] + (size_t)l * D * D, D, nullptr, wcs, D, r >> 4, r & 15, 128, 1024, scr, lane); return; } r -= 256;
        xpose_item(ap->in[I_WO] + (size_t)l * D * D, D, nullptr, wot, D, r >> 4, r & 15, 128, 0, scr, lane); return; }
    r -= 2 * IT_LAYER;
    if (r < IT_FFN) { const float* gf = ap->in[I_GFFN];
        if (r < 704) { xpose_item(ap->in[I_F1], FFD, gf, (bf16_t*)(ws + WS_WF13), D, r / 44, r % 44, 256, 0, scr, lane); return; } r -= 704;
        if (r < 704) { xpose_item(ap->in[I_F3], FFD, gf, (bf16_t*)(ws + WS_WF13), D, r / 44, r % 44, 256, 128, scr, lane); return; } r -= 704;
        if (FFN_DOWN_FP8) xpose_item_fp8(ap->in[I_F2], D, nullptr, W2_SCALE, ws + WS_WF2, FFD, r >> 4, r & 15, 128, 0, scr, lane);
        else xpose_item(ap->in[I_F2], D, nullptr, (bf16_t*)(ws + WS_WF2), FFD, r >> 4, r & 15, 128, 0, scr, lane);
        return; }
    r -= IT_FFN;
    { const int e = r / IT_EXP; r -= e * IT_EXP; const float* gf = ap->in[I_GFFN] + D;
        unsigned char* w13 = ws + WS_WM13 + (size_t)e * 2 * FFE * D; unsigned char* w2 = ws + WS_WM2 + (size_t)e * D * FFE;
        if (r < 896) { xpose_item_fp8(ap->in[I_M1] + (size_t)e * D * FFE, FFE, gf, W13_SCALE, w13, D, r / 56, r % 56, 256, 0, scr, lane); return; } r -= 896;
        if (r < 896) { xpose_item_fp8(ap->in[I_M3] + (size_t)e * D * FFE, FFE, gf, W13_SCALE, w13, D, r / 56, r % 56, 256, 128, scr, lane); return; } r -= 896;
        xpose_item_fp8(ap->in[I_M2] + (size_t)e * FFE * D, D, nullptr, W2_SCALE, w2, FFE, r >> 4, r & 15, 128, 0, scr, lane); }
}
constexpr int FL_WO0 = 256;
constexpr int FL_FFN = FL_WO0 + IT_FFN, FL_L1 = FL_FFN + IT_LAYER, FL_W13 = FL_L1 + NE * 1792, FL_TOTAL = FL_W13 + NE * 896;
__device__ __forceinline__ int filler_item(int i) {
    if (i < FL_WO0) return IT_LAYER - FL_WO0 + i;
    if (i < FL_FFN) return 2 * IT_LAYER + (i - FL_WO0);
    if (i < FL_L1) return IT_LAYER + (i - FL_FFN);
    if (i < FL_W13) { const int r = i - FL_L1, e = r / 1792; return 2 * IT_LAYER + IT_FFN + e * IT_EXP + (r - e * 1792); }
    const int r = i - FL_W13, e = r / 896; return 2 * IT_LAYER + IT_FFN + e * IT_EXP + 1792 + (r - e * 896);
}
template <int PART> __device__ __forceinline__ void prologue_phase(ArgP ap, LAS unsigned char* lds, int G, int c, int tid, int wid, int lane) {
    unsigned char* ws = ap->ws;
    LAS float* scr = (LAS float*)(lds + wid * 16640);
    const int gw = c * 8 + wid, NGW = G * 8;
    constexpr int IT_LO = PART == 0 ? 0 : IT_LAYER - FL_WO0, IT_HI = PART == 0 ? IT_LAYER - FL_WO0 : IT_TOTAL;
    if constexpr (PART != 0) { for (int it = IT_LO + gw; it < IT_HI; it += NGW) convert_item(ap, ws, it, scr, lane); }
    if constexpr (PART == 0) {
    const float* x = ap->in[I_X]; bf16_t* xb = (bf16_t*)(ws + WS_XB); float* ssq = (float*)(ws + WS_SSQ);
    f32x4 xv[8][4];
#pragma unroll
    for (int j = 0; j < 8; ++j) { const int m = gw + NGW * j; const f32x4* xr = (const f32x4*)(x + (size_t)(m < T ? m : 0) * D) + lane;
#pragma unroll
        for (int q = 0; q < 4; ++q) xv[j][q] = __builtin_nontemporal_load(xr + 64 * q); }
    for (int it = IT_LO + gw; it < IT_HI; it += NGW) convert_item(ap, ws, it, scr, lane);
#pragma unroll
    for (int j = 0; j < 8; ++j) { const int m = gw + NGW * j; if (m < T) { u32x2* o8 = (u32x2*)(xb + (size_t)m * D) + lane; float s = 0.f;
#pragma unroll
        for (int q = 0; q < 4; ++q) { const f32x4 v = xv[j][q]; s += (v[0] * v[0] + v[1] * v[1]) + (v[2] * v[2] + v[3] * v[3]); u32x2 w; w.x = cvt_pk_bf16(v[0], v[1]); w.y = cvt_pk_bf16(v[2], v[3]); o8[64 * q] = w; }
        s = wave_sum(s);
        if (lane < 4) ssq[(size_t)lane * T + m] = lane == 0 ? s : 0.f; } }
    { for (int m = gw + NGW * 8; m < T; m += NGW) { const f32x4* xr = (const f32x4*)(x + (size_t)m * D) + lane; u32x2* o8 = (u32x2*)(xb + (size_t)m * D) + lane; float s = 0.f;
#pragma unroll
            for (int j = 0; j < 4; ++j) { const f32x4 v = xr[64 * j]; s += (v[0] * v[0] + v[1] * v[1]) + (v[2] * v[2] + v[3] * v[3]); u32x2 w; w.x = cvt_pk_bf16(v[0], v[1]); w.y = cvt_pk_bf16(v[2], v[3]); o8[64 * j] = w; }
            s = wave_sum(s);
            if (lane < 4) ssq[(size_t)lane * T + m] = lane == 0 ? s : 0.f; } }
    { const float* cwsrc = ap->in[I_CONVW]; float* o = (float*)(ws + WS_CWT);
        for (int i = c * 512 + tid; i < 2 * D * 32; i += G * 512) { const int k = i & 31, ch = (i >> 5) & (D - 1), l = i >> 15; o[i] = k < CK ? cwsrc[((size_t)l * CK + k) * D + ch] : 0.f; } }
    { const float* sw = ap->in[I_SGW]; bf16_t* o = (bf16_t*)(ws + WS_SGW);
        for (int i = c * 512 + tid; i < 2 * 8 * 128 * 16; i += G * 512) { const int t = (i >> 4) & 127, s0 = (i & 15) * 8; const f32x4 a = *(const f32x4*)(sw + (size_t)i * 8), b = *(const f32x4*)(sw + (size_t)i * 8 + 4);
            float v[8] = {a[0], a[1], a[2], a[3], b[0], b[1], b[2], b[3]};
#pragma unroll
            for (int j = 0; j < 8; ++j) v[j] = (s0 + j <= t) ? v[j] : 0.f;
            *(u32x4*)(o + (size_t)i * 8) = pack8((f32x4){v[0], v[1], v[2], v[3]}, (f32x4){v[4], v[5], v[6], v[7]}); } }
    }
}

constexpr int FILL_BARRIERS = 12, FILL_WAVES = 7, FILL_PER_WAVE = (FL_TOTAL + 256 * FILL_WAVES - 1) / (256 * FILL_WAVES);
__device__ __forceinline__ int fill_min(int seq) { return seq < 3 ? 2 * seq + 1 : (seq < 6 ? seq + 3 : seq + 4); }
static_assert(FILL_PER_WAVE == 15, "filler list");
__device__ __forceinline__ void xcd_barrier_fill(const XcdBarrier& b, ArgP ap, unsigned char* ws, LAS unsigned char* lds, volatile LAS unsigned* relw, int seq, int c, int wid, int lane, int& fdone) {
    asm volatile("s_waitcnt vmcnt(0)" ::: "memory");
    __syncthreads();
    if (wid == 0) {
        if (threadIdx.x == 0) {
            unsigned* bar = b.bar;
            __builtin_amdgcn_s_waitcnt(0);
            unsigned nloc = b.st[0], nx = b.st[1];
            if (nloc == 0u) { xcd_barrier_complete(bar, b.x, nloc, nx); b.st[0] = nloc; b.st[1] = nx; }
            const unsigned old = xb_add(&bar[XB_XSUB(b.x)], 1u);
            const unsigned gen = old / nloc;
            if (old + 1u == (gen + 1u) * nloc) {
                __builtin_amdgcn_fence(__ATOMIC_RELEASE, "agent");
                asm volatile("s_waitcnt vmcnt(0)" ::: "memory");
                const unsigned og = xb_add(&bar[XB_TOP], 1u);
                const unsigned tg = og / nx;
                if (og + 1u == (tg + 1u) * nx) xb_add(&bar[XB_TOPGEN], 1u);
                else XB_SPIN(xb_ld(&bar[XB_TOPGEN]) == tg, bar);
                __builtin_amdgcn_fence(__ATOMIC_ACQUIRE, "agent");
                xb_add(&bar[XB_XGEN(b.x)], 1u);
                asm volatile("s_waitcnt vmcnt(0)" ::: "memory");
            } else {
                XB_SPIN(xb_ld(&bar[XB_XGEN(b.x)]) == gen, bar);
                __builtin_amdgcn_fence(__ATOMIC_ACQUIRE, "agent");
                asm volatile("s_waitcnt vmcnt(0)" ::: "memory");
            }
            *relw = (unsigned)seq + 1u;
        }
    } else {
        LAS float* scr = (LAS float*)(lds + (wid - 1) * 16640);
        const int fw = c * FILL_WAVES + (wid - 1), need = fill_min(seq);
        int done = fdone;
        const bool deleg = FILL_DELEGATE && gridDim.x == 256;
        if (deleg && seq == 5 && c >= 128) {
            for (int k = 0; k < 4; ++k) { const int j = 7 + (k >> 1); int i;
                if ((k & 1) == 0) { if (done > j) continue; done = j + 1; i = fw + 256 * FILL_WAVES * j; } else i = fw - 128 * FILL_WAVES + 256 * FILL_WAVES * j;
                if (i < FL_TOTAL) convert_item(ap, ws, filler_item(i), scr, lane); }
        }
        while (done < FILL_PER_WAVE) {
            if (deleg && c < 128 && (done == 7 || done == 8)) { ++done; continue; }
            if (done >= need && (unsigned)__builtin_amdgcn_readfirstlane((int)*relw) == (unsigned)seq + 1u) break;
            const int i = fw + 256 * FILL_WAVES * done;
            if (i < FL_TOTAL) convert_item(ap, ws, filler_item(i), scr, lane);
            ++done;
        }
        fdone = done;
    }
    asm volatile("s_waitcnt lgkmcnt(0)" ::: "memory"); __builtin_amdgcn_s_barrier(); asm volatile("" ::: "memory");
}

template <int J, int ROT> __device__ __forceinline__ void conv_row(f32x2 (&acc)[32], const f32x2 (&w)[32], LAS unsigned char* p) {
    constexpr int LO = J - 30 > 0 ? J - 30 : 0, HI = J < 31 ? J : 31, SLOT = (J + ROT) % 62;
    const unsigned raw = *(const LAS unsigned*)(p + SLOT * 2048); const f32x2 v = (f32x2){bf_lo(raw), bf_hi(raw)};
#pragma unroll
    for (int i = LO; i <= HI; ++i) acc[i] += w[J - i] * v;
    if constexpr ((J & 3) == 3) __builtin_amdgcn_sched_barrier(0);
}
template <int ROT, int... Js> __device__ __forceinline__ void conv_rows(f32x2 (&acc)[32], const f32x2 (&w)[32], LAS unsigned char* p, std::integer_sequence<int, Js...>) { (conv_row<Js, ROT>(acc, w, p), ...); }
__device__ __forceinline__ void conv_ln_store(LAS unsigned char* lds, f32x2 (&acc)[32], bf16_t* Cp, int t0, f32x2 g2, f32x2 b2, int tid, int wid, int lane) {
    float tot[2];
#pragma unroll
    for (int pass = 0; pass < 2; ++pass) {
        float val[32];
#pragma unroll
        for (int i = 0; i < 32; ++i) val[i] = pass == 0 ? acc[i].x + acc[i].y : acc[i].x * acc[i].x + acc[i].y * acc[i].y;
#pragma unroll
        for (int h = 16; h >= 1; h >>= 1) { const bool up = (lane & h) != 0;
#pragma unroll
            for (int k = 0; k < h; ++k) { const float lo = val[k], hi = val[k + h]; const float send = up ? lo : hi, keep = up ? hi : lo; val[k] = keep + __shfl_xor(send, h); } }
        tot[pass] = val[0] + __shfl_xor(val[0], 32);
    }
    LAS float* red = (LAS float*)(lds + 62 * 2048); LAS f32x2* stat = (LAS f32x2*)(lds + 62 * 2048 + 2048);
    red[wid * 64 + lane] = lane < 32 ? tot[0] : tot[1];
    asm volatile("s_waitcnt lgkmcnt(0)" ::: "memory"); __builtin_amdgcn_s_barrier(); asm volatile("" ::: "memory");
    if (tid < 32) { float s1 = 0.f, s2 = 0.f;
#pragma unroll
        for (int wv = 0; wv < 8; ++wv) { s1 += red[wv * 64 + tid]; s2 += red[wv * 64 + 32 + tid]; }
        const float mean = s1 * (1.0f / D), var = s2 * (1.0f / D) - mean * mean; stat[tid] = (f32x2){mean, __builtin_amdgcn_rsqf(var + EPS)}; }
    asm volatile("s_waitcnt lgkmcnt(0)" ::: "memory"); __builtin_amdgcn_s_barrier(); asm volatile("" ::: "memory");
    unsigned* outp = (unsigned*)(Cp + (size_t)t0 * D) + tid;
#pragma unroll
    for (int i = 0; i < 32; ++i) { const f32x2 st = stat[i]; const f32x2 y = (acc[i] - st.x) * st.y * g2 + b2; outp[(size_t)i * (D / 2)] = cvt_pk_bf16(siluf_(y.x), siluf_(y.y)); }
}
__device__ __forceinline__ void conv_load_w(f32x2 (&w)[32], const float* cw, int tid) {
    const f32x4* w0 = (const f32x4*)(cw + (size_t)(2 * tid) * 32); const f32x4* w1 = w0 + 8;
#pragma unroll
    for (int k4 = 0; k4 < 8; ++k4) { const f32x4 a = w0[k4], b = w1[k4];
#pragma unroll
        for (int i = 0; i < 4; ++i) w[4 * k4 + i] = (f32x2){a[i], b[i]}; }
}
__device__ __forceinline__ void conv_span(LAS unsigned char* lds, int span, const bf16_t* Ap, bf16_t* Cp, const float* cw, const float* cb, const float* lng, const float* lnb, int tid, int wid, int lane) {
    asm volatile("" : "+v"(tid));
    const int t0 = span * 64, s0 = t0 & (SEQ - 1);
    for (int q = wid; q < 124; q += 8) { const int j = q >> 1, hf = q & 1;
        if (s0 + j >= 30) __builtin_amdgcn_global_load_lds((const unsigned*)(Ap + (size_t)(t0 - 30 + j) * D + hf * 512 + lane * 8), (LAS unsigned*)(lds + j * 2048 + hf * 1024), 16, 0, 0);
        else *(LAS u32x4*)(lds + j * 2048 + hf * 1024 + lane * 16) = (u32x4){0u, 0u, 0u, 0u}; }
    f32x2 w[32];
    conv_load_w(w, cw, tid);
    const f32x2 bias = *(const f32x2*)(cb + 2 * tid), g2 = *(const f32x2*)(lng + 2 * tid), b2 = *(const f32x2*)(lnb + 2 * tid);
    asm volatile("s_waitcnt vmcnt(0) lgkmcnt(0)" ::: "memory"); __builtin_amdgcn_s_barrier(); asm volatile("" ::: "memory");
    f32x2 acc[32];
#pragma unroll
    for (int i = 0; i < 32; ++i) acc[i] = bias;
    conv_rows<0>(acc, w, lds + tid * 4, std::make_integer_sequence<int, 62>{});
    asm volatile("s_waitcnt lgkmcnt(0)" ::: "memory"); __builtin_amdgcn_s_barrier(); asm volatile("" ::: "memory");
    for (int q = wid; q < 64; q += 8) { const int j = q >> 1, hf = q & 1;
        __builtin_amdgcn_global_load_lds((const unsigned*)(Ap + (size_t)(t0 + 32 + j) * D + hf * 512 + lane * 8), (LAS unsigned*)(lds + j * 2048 + hf * 1024), 16, 0, 0); }
    conv_ln_store(lds, acc, Cp, t0, g2, b2, tid, wid, lane);
    f32x2 w2[32];
    conv_load_w(w2, cw, tid);
    asm volatile("s_waitcnt vmcnt(0) lgkmcnt(0)" ::: "memory"); __builtin_amdgcn_s_barrier(); asm volatile("" ::: "memory");
#pragma unroll
    for (int i = 0; i < 32; ++i) acc[i] = bias;
    conv_rows<32>(acc, w2, lds + tid * 4, std::make_integer_sequence<int, 62>{});
    conv_ln_store(lds, acc, Cp, t0 + 32, g2, b2, tid, wid, lane);
    asm volatile("s_waitcnt lgkmcnt(0)" ::: "memory"); __builtin_amdgcn_s_barrier(); asm volatile("" ::: "memory");
}

__device__ __forceinline__ unsigned off_b(unsigned row, unsigned ch) { return 256u * row + 16u * (ch ^ (((row & 3) << 2) | ((row >> 2) & 3))); }
__device__ __forceinline__ unsigned tr_read_addr_16(unsigned lane, unsigned cb, unsigned ks, unsigned t) { const unsigned g = lane >> 4, q = (lane & 15) >> 2, p = lane & 3; return off_b(32 * ks + 8 * g + 4 * t + q, 2 * cb + (p >> 1)) + 8 * (p & 1); }
__device__ __forceinline__ void sgu_load_gv(u32x4 (&raw)[4], const bf16_t* GV, int unit, int tid) {
    const int g = unit & 7, bn = unit >> 3, ch = tid & 15;
#pragma unroll
    for (int k = 0; k < 4; ++k) raw[k] = *(const u32x4*)(GV + (size_t)(bn * CHUNK + (tid >> 4) + 32 * k) * D + g * 128 + 8 * ch);
}
__device__ __forceinline__ void sgu_phase(LAS unsigned char* lds, int c, int G, const bf16_t* GV, const bf16_t* GU, bf16_t* Y, const float* lng, const float* lnb, const bf16_t* Wm, const float* sgb, int tid, int wid, int lane) {
    constexpr int NU = (T / CHUNK) * 8;
    const int fr = lane & 15, fq = lane >> 4, ch = tid & 15;
    u32x4 raw[4];
    if (c < NU) sgu_load_gv(raw, GV, c, tid);
    for (int unit = c; unit < NU; unit += G) {
        const int g = unit & 7, bn = unit >> 3, t0 = bn * CHUNK, c0 = g * 128, t = 16 * wid + fr;
        const f32x4 ga = *(const f32x4*)(lng + c0 + 8 * ch), gb = *(const f32x4*)(lng + c0 + 8 * ch + 4), ba = *(const f32x4*)(lnb + c0 + 8 * ch), bb = *(const f32x4*)(lnb + c0 + 8 * ch + 4);
        const bf16_t* wrow = Wm + ((size_t)g * 128 + t) * 128 + 8 * fq;
        bf16x8 bfrag[4];
#pragma unroll
        for (int ks = 0; ks < 4; ++ks) bfrag[ks] = *(const bf16x8*)(wrow + 32 * ks);
        u32x2 gu[8];
#pragma unroll
        for (int cb = 0; cb < 8; ++cb) gu[cb] = *(const u32x2*)(GU + (size_t)(t0 + t) * D + c0 + 16 * cb + 4 * fq);
        const float bias = sgb[g * 128 + t];
#pragma unroll
        for (int k = 0; k < 4; ++k) { const int s = (tid >> 4) + 32 * k; const f32x4 a = unpk_lo(raw[k]), b = unpk_hi(raw[k]);
            float sum = (a[0] + a[1]) + (a[2] + a[3]) + (b[0] + b[1]) + (b[2] + b[3]);
            float sq = (a[0] * a[0] + a[1] * a[1]) + (a[2] * a[2] + a[3] * a[3]) + (b[0] * b[0] + b[1] * b[1]) + (b[2] * b[2] + b[3] * b[3]);
#pragma unroll
            for (int o = 1; o < 16; o <<= 1) { sum += __shfl_xor(sum, o); sq += __shfl_xor(sq, o); }
            const float mean = sum * (1.0f / 128.0f), var = sq * (1.0f / 128.0f) - mean * mean, rstd = __builtin_amdgcn_rsqf(var + EPS);
            const f32x4 ya = (a - mean) * rstd * ga + ba, yb = (b - mean) * rstd * gb + bb;
            *(LAS u32x4*)(lds + off_b(s, ch)) = pack8(ya, yb); }
        if (unit + G < NU) sgu_load_gv(raw, GV, unit + G, tid);
        __syncthreads();
        f32x4 acc[8];
#pragma unroll
        for (int cb = 0; cb < 8; ++cb) acc[cb] = (f32x4){0.f, 0.f, 0.f, 0.f};
        const int nks = (wid >> 1) + 1;
#pragma unroll
        for (int ks = 0; ks < 4; ++ks) if (ks < nks) {
#pragma unroll
            for (int cb = 0; cb < 8; ++cb) { const bf16x4 lo = __builtin_amdgcn_ds_read_tr16_b64_v4i16((LAS bf16x4*)(lds + tr_read_addr_16(lane, cb, ks, 0))), hi = __builtin_amdgcn_ds_read_tr16_b64_v4i16((LAS bf16x4*)(lds + tr_read_addr_16(lane, cb, ks, 1)));
                const bf16x8 afrag = (bf16x8){lo[0], lo[1], lo[2], lo[3], hi[0], hi[1], hi[2], hi[3]};
                acc[cb] = __builtin_amdgcn_mfma_f32_16x16x32_bf16(afrag, bfrag[ks], acc[cb], 0, 0, 0); } }
#pragma unroll
        for (int cb = 0; cb < 8; ++cb) { u32x2 o; o.x = cvt_pk_bf16(bf_lo(gu[cb].x) * (acc[cb][0] + bias), bf_hi(gu[cb].x) * (acc[cb][1] + bias)); o.y = cvt_pk_bf16(bf_lo(gu[cb].y) * (acc[cb][2] + bias), bf_hi(gu[cb].y) * (acc[cb][3] + bias));
            *(u32x2*)(Y + (size_t)(t0 + t) * D + c0 + 16 * cb + 4 * fq) = o; }
        __syncthreads();
    }
}

struct SguRegs { u32x4 raw[4]; };
__device__ __forceinline__ void sgu_issue(SguRegs& r, int unit, const bf16_t* GV, const bf16_t* GU, int tid, int wid, int lane) {
    const int fr = lane & 15, fq = lane >> 4, g = unit & 7, bn = unit >> 3, t0 = bn * CHUNK, c0 = g * 128, t = 16 * wid + fr;
    sgu_load_gv(r.raw, GV, unit, tid); (void)GU; (void)fq; (void)t0; (void)c0; (void)t;
}
__device__ __forceinline__ void sgu_finish(LAS unsigned char* lds, const SguRegs& r, int unit, const bf16_t* GU, bf16_t* Y, const float* lng, const float* lnb, const bf16_t* Wm, const float* sgb, int tid, int wid, int lane) {
    const int fr = lane & 15, fq = lane >> 4, ch = tid & 15, g = unit & 7, bn = unit >> 3, t0 = bn * CHUNK, c0 = g * 128, t = 16 * wid + fr;
    const f32x4 ga = *(const f32x4*)(lng + c0 + 8 * ch), gb = *(const f32x4*)(lng + c0 + 8 * ch + 4), ba = *(const f32x4*)(lnb + c0 + 8 * ch), bb = *(const f32x4*)(lnb + c0 + 8 * ch + 4);
    const bf16_t* wrow = Wm + ((size_t)g * 128 + t) * 128 + 8 * fq;
    bf16x8 bfrag[4];
#pragma unroll
    for (int ks = 0; ks < 4; ++ks) bfrag[ks] = *(const bf16x8*)(wrow + 32 * ks);
    const float bias = sgb[g * 128 + t];
    u32x2 gu[8];
#pragma unroll
    for (int cb = 0; cb < 8; ++cb) gu[cb] = *(const u32x2*)(GU + (size_t)(t0 + t) * D + c0 + 16 * cb + 4 * fq);
#pragma unroll
    for (int k = 0; k < 4; ++k) { const int sr = (tid >> 4) + 32 * k; const f32x4 a = unpk_lo(r.raw[k]), b = unpk_hi(r.raw[k]);
        float sum = (a[0] + a[1]) + (a[2] + a[3]) + (b[0] + b[1]) + (b[2] + b[3]);
        float sq = (a[0] * a[0] + a[1] * a[1]) + (a[2] * a[2] + a[3] * a[3]) + (b[0] * b[0] + b[1] * b[1]) + (b[2] * b[2] + b[3] * b[3]);
#pragma unroll
        for (int o = 1; o < 16; o <<= 1) { sum += __shfl_xor(sum, o); sq += __shfl_xor(sq, o); }
        const float mean = sum * (1.0f / 128.0f), var = sq * (1.0f / 128.0f) - mean * mean, rstd = __builtin_amdgcn_rsqf(var + EPS);
        const f32x4 ya = (a - mean) * rstd * ga + ba, yb = (b - mean) * rstd * gb + bb;
        *(LAS u32x4*)(lds + off_b(sr, ch)) = pack8(ya, yb); }
    asm volatile("s_waitcnt lgkmcnt(0)" ::: "memory"); __builtin_amdgcn_s_barrier(); asm volatile("" ::: "memory");
    f32x4 acc[8];
#pragma unroll
    for (int cb = 0; cb < 8; ++cb) acc[cb] = (f32x4){0.f, 0.f, 0.f, 0.f};
    const int nks = (wid >> 1) + 1;
#pragma unroll
    for (int ks = 0; ks < 4; ++ks) if (ks < nks) {
#pragma unroll
        for (int cb = 0; cb < 8; ++cb) { const bf16x4 lo = __builtin_amdgcn_ds_read_tr16_b64_v4i16((LAS bf16x4*)(lds + tr_read_addr_16(lane, cb, ks, 0))), hi = __builtin_amdgcn_ds_read_tr16_b64_v4i16((LAS bf16x4*)(lds + tr_read_addr_16(lane, cb, ks, 1)));
            const bf16x8 afrag = (bf16x8){lo[0], lo[1], lo[2], lo[3], hi[0], hi[1], hi[2], hi[3]};
            acc[cb] = __builtin_amdgcn_mfma_f32_16x16x32_bf16(afrag, bfrag[ks], acc[cb], 0, 0, 0); } }
#pragma unroll
    for (int cb = 0; cb < 8; ++cb) { u32x2 o; o.x = cvt_pk_bf16(bf_lo(gu[cb].x) * (acc[cb][0] + bias), bf_hi(gu[cb].x) * (acc[cb][1] + bias)); o.y = cvt_pk_bf16(bf_lo(gu[cb].y) * (acc[cb][2] + bias), bf_hi(gu[cb].y) * (acc[cb][3] + bias));
        *(u32x2*)(Y + (size_t)(t0 + t) * D + c0 + 16 * cb + 4 * fq) = o; }
    asm volatile("s_waitcnt lgkmcnt(0)" ::: "memory"); __builtin_amdgcn_s_barrier(); asm volatile("" ::: "memory");
}
__device__ __forceinline__ void mix_fused(LAS unsigned char* lds, int span, int u0, int G, const bf16_t* Ap, bf16_t* Cp, const float* cw, const float* cb, const float* lng, const float* lnb,
                                          const bf16_t* GV, const bf16_t* GU, bf16_t* Y, const float* slng, const float* slnb, const bf16_t* Wm, const float* sgb, int tid, int wid, int lane) {
    constexpr int NU = (T / CHUNK) * 8;
    LAS unsigned char* cl = lds + 32768;
    SguRegs ra;
    int unit = u0;
    sgu_issue(ra, unit, GV, GU, tid, wid, lane);
    const int t0 = span * 64, s0 = t0 & (SEQ - 1);
    for (int q = wid; q < 124; q += 8) { const int j = q >> 1, hf = q & 1;
        if (s0 + j >= 30) __builtin_amdgcn_global_load_lds((const unsigned*)(Ap + (size_t)(t0 - 30 + j) * D + hf * 512 + lane * 8), (LAS unsigned*)(cl + j * 2048 + hf * 1024), 16, 0, 0);
        else *(LAS u32x4*)(cl + j * 2048 + hf * 1024 + lane * 16) = (u32x4){0u, 0u, 0u, 0u}; }
    f32x2 acc[32];
    { f32x2 w[32];
      conv_load_w(w, cw, tid);
      const f32x2 bias = *(const f32x2*)(cb + 2 * tid);
      asm volatile("s_waitcnt vmcnt(0) lgkmcnt(0)" ::: "memory"); __builtin_amdgcn_s_barrier(); asm volatile("" ::: "memory");
#pragma unroll
      for (int i = 0; i < 32; ++i) acc[i] = bias;
      conv_rows<0>(acc, w, cl + tid * 4, std::make_integer_sequence<int, 62>{}); }
    asm volatile("s_waitcnt lgkmcnt(0)" ::: "memory"); __builtin_amdgcn_s_barrier(); asm volatile("" ::: "memory");
    for (int q = wid; q < 64; q += 8) { const int j = q >> 1, hf = q & 1;
        __builtin_amdgcn_global_load_lds((const unsigned*)(Ap + (size_t)(t0 + 32 + j) * D + hf * 512 + lane * 8), (LAS unsigned*)(cl + j * 2048 + hf * 1024), 16, 0, 0); }
    __builtin_amdgcn_sched_barrier(0); conv_ln_store(cl, acc, Cp, t0, *(const f32x2*)(lng + 2 * tid), *(const f32x2*)(lnb + 2 * tid), tid, wid, lane);
    __builtin_amdgcn_sched_barrier(0); sgu_finish(lds, ra, unit, GU, Y, slng, slnb, Wm, sgb, tid, wid, lane);
    unit += G;
    { f32x2 w2[32];
      asm volatile("s_waitcnt vmcnt(0) lgkmcnt(0)" ::: "memory"); __builtin_amdgcn_s_barrier(); asm volatile("" ::: "memory");
      conv_load_w(w2, cw, tid);
      const f32x2 bias = *(const f32x2*)(cb + 2 * tid);
      if (unit < NU) sgu_issue(ra, unit, GV, GU, tid, wid, lane);
#pragma unroll
      for (int i = 0; i < 32; ++i) acc[i] = bias;
      conv_rows<32>(acc, w2, cl + tid * 4, std::make_integer_sequence<int, 62>{}); }
    __builtin_amdgcn_sched_barrier(0); conv_ln_store(cl, acc, Cp, t0 + 32, *(const f32x2*)(lng + 2 * tid), *(const f32x2*)(lnb + 2 * tid), tid, wid, lane);
    __builtin_amdgcn_sched_barrier(0);
    SguRegs rb;
    const int u1 = unit, u2 = unit + G, u3 = unit + 2 * G;
    if (u2 < NU) sgu_issue(rb, u2, GV, GU, tid, wid, lane);
    __builtin_amdgcn_sched_barrier(0); if (u1 < NU) sgu_finish(lds, ra, u1, GU, Y, slng, slnb, Wm, sgb, tid, wid, lane);
    __builtin_amdgcn_sched_barrier(0); if (u3 < NU) sgu_issue(ra, u3, GV, GU, tid, wid, lane);
    __builtin_amdgcn_sched_barrier(0); if (u2 < NU) sgu_finish(lds, rb, u2, GU, Y, slng, slnb, Wm, sgb, tid, wid, lane);
    __builtin_amdgcn_sched_barrier(0); if (u3 < NU) sgu_finish(lds, ra, u3, GU, Y, slng, slnb, Wm, sgb, tid, wid, lane);
}

__device__ __forceinline__ void route_phase(ArgP ap, LAS unsigned char* lds, unsigned* cntw, unsigned char* listb, int G, int c, int tid, int wid, int lane) {
    const float* plg = (const float*)((const bf16_t*)(ap->ws + WS_H) + 5 * PLANE); const float* ssq = (const float*)(ap->ws + WS_SSQ);
    int* rowtok = (int*)listb; float* rowgate = (float*)(listb + 512 * 1024); float* rowrs = (float*)(listb + 1024 * 1024);
    LAS int* s_lcnt = (LAS int*)lds; LAS int* s_gb = s_lcnt + 8;
    for (int blk = c; blk < T / 64; blk += G) {
        if (tid < 8) s_lcnt[tid] = 0;
        __syncthreads();
        int r0 = 0, r1 = 0, e0 = 0, e1 = 0; float w0 = 0.f, rs = 0.f; const int tok = blk * 64 + tid;
        if (tid < 64) { f32x4 la = (f32x4){0.f, 0.f, 0.f, 0.f}, lb = la; float ss = 0.f;
#pragma unroll
            for (int pn = 0; pn < 4; ++pn) { const float* q = plg + ((size_t)pn * T + tok) * 8; la += *(const f32x4*)q; lb += *(const f32x4*)(q + 4); ss += ssq[(size_t)pn * T + tok]; }
            rs = __builtin_amdgcn_rsqf(ss * (1.0f / D) + EPS);
            const float dot[8] = {la[0], la[1], la[2], la[3], lb[0], lb[1], lb[2], lb[3]};
            float bv = dot[0] * rs; int bi = 0;
#pragma unroll
            for (int e = 1; e < 8; ++e) { const float l = dot[e] * rs; if (l > bv) { bv = l; bi = e; } }
            float sv = -3.0e38f; int si = 0;
#pragma unroll
            for (int e = 0; e < 8; ++e) { const float l = dot[e] * rs; if (e != bi && l > sv) { sv = l; si = e; } }
            w0 = 1.0f / (1.0f + __expf(sv - bv)); e0 = bi; e1 = si;
            r0 = __hip_atomic_fetch_add(s_lcnt + e0, 1, __ATOMIC_RELAXED, __HIP_MEMORY_SCOPE_WORKGROUP); r1 = __hip_atomic_fetch_add(s_lcnt + e1, 1, __ATOMIC_RELAXED, __HIP_MEMORY_SCOPE_WORKGROUP); }
        __syncthreads();
        if (tid < 8) s_gb[tid] = (int)__hip_atomic_fetch_add(cntw + 64 * tid, (unsigned)s_lcnt[tid], __ATOMIC_RELAXED, __HIP_MEMORY_SCOPE_AGENT);
        __syncthreads();
        if (tid < 64) { const int i0 = e0 * 16384 + s_gb[e0] + r0, i1 = e1 * 16384 + s_gb[e1] + r1;
            rowtok[i0] = 2 * tok; rowgate[i0] = w0; rowrs[i0] = rs;
            rowtok[i1] = 2 * tok + 1; rowgate[i1] = 1.0f - w0; rowrs[i1] = rs; }
        __syncthreads();
    }
}
__device__ __forceinline__ MoeTiles moe_tiles(unsigned* ctl) {
    MoeTiles mt; int acc = 0;
#pragma unroll
    for (int e = 0; e < NE; ++e) { int cn = (int)__hip_atomic_load(ctl + CW_CNT + 64 * e, __ATOMIC_RELAXED, __HIP_MEMORY_SCOPE_AGENT); cn = cn < 0 ? 0 : (cn > T ? T : cn);
        cn = __builtin_amdgcn_readfirstlane(cn); mt.cnt[e] = cn; mt.tstart[e] = acc; acc += (cn + 255) >> 8; }
    mt.tstart[NE] = acc; return mt;
}

__global__ void __launch_bounds__(512, 2) mk_fwd(Args args) {
    extern __shared__ __attribute__((aligned(16))) unsigned char lds_raw[];
    LAS unsigned char* lds = (LAS unsigned char*)lds_raw;
    LAS unsigned char* misc = lds + MISC_OFF;
    const int G = gridDim.x, c = blockIdx.x;
    if (threadIdx.x < 4) ((LAS unsigned*)(misc + M_XB))[threadIdx.x] = 0u;
    __syncthreads();
    const int lo = args.ph_lo, hi = args.ph_hi;
    int fdone = 0;
    const bool fill = (lo == 0 && hi == NPHASE && G == 256 && PH_MASK_ALL);
    XcdBarrier bar; bar.bar = (unsigned*)(args.ws + WS_CTL) + CW_BAR; bar.x = 0; bar.st = (volatile LAS unsigned*)(misc + M_XB);
    if (hi - lo > 1) bar = xcd_barrier_post((unsigned*)(args.ws + WS_CTL) + CW_BAR, (volatile LAS unsigned*)(misc + M_XB));
#define IN(k) (((PH_MASK >> ((k) >= 7 && (k) <= 10 ? (k) - 6 : (k))) & 1) && lo <= (k) && (k) < hi)
#define GRID_BAR(k) do { if (IN(k) && IN((k) + 1)) { XcdBarrier b_ = bar; asm volatile("" : "+s"(b_.bar), "+s"(b_.x)); if (fill && (k) < FILL_BARRIERS) xcd_barrier_fill(b_, ap, ws, lds, (volatile LAS unsigned*)(misc + M_XB + 8), (k), c, wid, lane, fdone); else if (FLAT_BAR && fill) flat_barrier((unsigned*)(ws + WS_CTL), CW_FLAT + 256 * ((k) - FILL_BARRIERS), c, (unsigned)G); else xcd_barrier(b_); if (DBL_BAR) xcd_barrier(b_); } } while (0)
#ifndef REP_MASK
#define REP_MASK 0
#endif
#ifndef DBL_BAR
#define DBL_BAR 0
#endif
#define NREP(k) (((REP_MASK >> (k)) & 1) ? 2 : 1)
#define PHASE_LOCALS ArgP ap = fresh_args(); unsigned char* ws = ap->ws; int tid = threadIdx.x; asm volatile("" : "+v"(tid)); const int lane = tid & 63, wid = __builtin_amdgcn_readfirstlane(tid >> 6); \
    bf16_t* planes = (bf16_t*)(ws + WS_H); bf16_t* xb = (bf16_t*)(ws + WS_XB); float* ssq = (float*)(ws + WS_SSQ); float* xw = ap->out; unsigned* ctl = (unsigned*)(ws + WS_CTL); \
    (void)lane; (void)wid; (void)planes; (void)xb; (void)ssq; (void)xw; (void)ctl;

    if (IN(0)) { PHASE_LOCALS for (int rep = 0; rep < NREP(0); ++rep) { prologue_phase<0>(ap, lds, G, c, tid, wid, lane); if (!fill) prologue_phase<1>(ap, lds, G, c, tid, wid, lane); __syncthreads(); } GRID_BAR(0); }

#pragma unroll
    for (int l = 0; l < 2; ++l) {
        const int pb = 1 + 6 * l;
        if (IN(pb)) { PHASE_LOCALS
            PlainSched S; S.so.init(T / 256, NIN / 256, G, c); S.A = (const char*)xb; S.Bt = (const char*)((bf16_t*)(ws + WS_WIN) + (size_t)l * NIN * D); S.K = D;
            EpiA E{planes, ssq};
            build_rs_table(S, misc, ssq, tid);
            for (int rep = 0; rep < NREP(1); ++rep) pg8::gemm_phase<EpiA, PlainSched, true>(lds, misc, S, E);
            GRID_BAR(pb);
        }
        if (IN(pb + 1)) { PHASE_LOCALS
            const float* cw = (const float*)(ws + WS_CWT) + (size_t)l * D * 32;
#define PHASE_B_BODY \
            for (int sp = c; sp < T / 64; sp += G) conv_span(lds, sp, planes, planes + 5 * PLANE, cw, ap->in[I_CONVB] + l * D, ap->in[I_CLNG] + l * D, ap->in[I_CLNB] + l * D, tid, wid, lane); \
            sgu_phase(lds, c, G, planes + 2 * PLANE, planes + 1 * PLANE, planes + 6 * PLANE, ap->in[I_SLNG] + l * D, ap->in[I_SLNB] + l * D, \
                      (const bf16_t*)(ws + WS_SGW) + (size_t)l * 8 * 128 * 128, ap->in[I_SGB] + l * 8 * 128, tid, wid, lane); \

#if MIX_FUSED && !((REP_MASK >> 2) & 1) && !defined(REP_CONV) && !defined(REP_SGU)
            if (G * 64 == T) mix_fused(lds, c, c, G, planes, planes + 5 * PLANE, cw, ap->in[I_CONVB] + l * D, ap->in[I_CLNG] + l * D, ap->in[I_CLNB] + l * D, planes + 2 * PLANE, planes + 1 * PLANE, planes + 6 * PLANE,
                                       ap->in[I_SLNG] + l * D, ap->in[I_SLNB] + l * D, (const bf16_t*)(ws + WS_SGW) + (size_t)l * 8 * 128 * 128, ap->in[I_SGB] + l * 8 * 128, tid, wid, lane);
            else { PHASE_B_BODY }
#else
            PHASE_B_BODY
#endif
#if (REP_MASK >> 2) & 1
            PHASE_B_BODY
#endif
#undef PHASE_B_BODY
#ifdef REP_CONV
            for (int sp = c; sp < T / 64; sp += G) conv_span(lds, sp, planes, planes + 5 * PLANE, cw, ap->in[I_CONVB] + l * D, ap->in[I_CLNG] + l * D, ap->in[I_CLNB] + l * D, tid, wid, lane);
#endif
#ifdef REP_SGU
            sgu_phase(lds, c, G, planes + 2 * PLANE, planes + 1 * PLANE, planes + 6 * PLANE, ap->in[I_SLNG] + l * D, ap->in[I_SLNB] + l * D, (const bf16_t*)(ws + WS_SGW) + (size_t)l * 8 * 128 * 128, ap->in[I_SGB] + l * 8 * 128, tid, wid, lane);
#endif
            GRID_BAR(pb + 1);
        }
        if (IN(pb + 2)) { PHASE_LOCALS
            PairSched S; S.so.init(T / 256, D / 256, G, c); S.A = (const char*)(planes + 5 * PLANE); S.Bt = (const char*)((bf16_t*)(ws + WS_WCS) + (size_t)l * 2048 * D); S.K = D;
            EpiC E{planes, planes + 3 * PLANE};
            for (int rep = 0; rep < NREP(3); ++rep) pg8::gemm_phase<EpiC, PairSched, true>(lds, misc, S, E);
            GRID_BAR(pb + 2);
        }
        if (IN(pb + 3)) { PHASE_LOCALS
            PlainSched S; S.so.init(T / 256, D / 256, G, c); S.A = (const char*)planes; S.Bt = (const char*)((bf16_t*)(ws + WS_WO) + (size_t)l * D * D); S.K = D;
            if (l == 1) { pg8::Unit u0; if (S.next(0, u0)) { const float* gf = ap->in[I_GFFN] + D; const float* rt = ap->in[I_ROUTER];
                    for (int i = tid; i < 8 * 256; i += 512) { const int e = i >> 8, cg = u0.pn * 256 + (i & 255); ((LAS float*)(misc + M_AUX))[i] = gf[cg] * rt[(size_t)cg * 8 + e]; } }
                __syncthreads(); }
            if (l == 0) {
                EpiD<true, false> E{ap->in[I_X], xb, ssq, nullptr, nullptr, 1.0f};
                if (NREP(4) > 1) { EpiD<true, false> E0{E.xf, planes + 3 * PLANE, (float*)(planes + 5 * PLANE), nullptr, nullptr, 1.0f}; pg8::gemm_phase<EpiD<true, false>, PlainSched, true>(lds, misc, S, E0); }
                pg8::gemm_phase<EpiD<true, false>, PlainSched, true>(lds, misc, S, E);
            } else {
                EpiD<false, true> E{nullptr, xb, ssq, (unsigned char*)(planes + 4 * PLANE), (float*)(planes + 5 * PLANE), 1.0f};
                pg8::gemm_phase<EpiD<false, true>, PlainSched, true>(lds, misc, S, E);
            }
            GRID_BAR(pb + 3);
        }
        if (l == 0) {
            if (IN(5)) { PHASE_LOCALS
                PlainSched S; S.so.init(T / 256, 2 * FFD / 256, G, c); S.A = (const char*)xb; S.Bt = (const char*)(ws + WS_WF13); S.K = D;
                EpiE E{planes, ssq, FFD, FFN_DOWN_FP8};
                build_rs_table(S, misc, ssq, tid);
                for (int rep = 0; rep < NREP(5); ++rep) pg8::gemm_phase<EpiE, PlainSched, true>(lds, misc, S, E);
                GRID_BAR(5);
            }
            if (IN(6)) { PHASE_LOCALS
                PlainSchedT<FFN_DOWN_FP8 != 0> S; S.so.init(T / 256, D / 256, G, c); S.A = (const char*)planes; S.Bt = (const char*)(ws + WS_WF2); S.K = FFN_DOWN_FP8 ? FFD / 2 : FFD;
                EpiD<false, false> E{nullptr, xb, ssq, nullptr, nullptr, FFN_DOWN_FP8 ? 1.0f / W2_SCALE : 1.0f};
                if (NREP(6) > 1) { EpiD<false, false> E0{nullptr, planes + 5 * PLANE, (float*)(planes + 6 * PLANE), nullptr, nullptr, FFN_DOWN_FP8 ? 1.0f / W2_SCALE : 1.0f}; pg8::gemm_phase<EpiD<false, false>, PlainSchedT<FFN_DOWN_FP8 != 0>, true>(lds, misc, S, E0); }
                pg8::gemm_phase<EpiD<false, false>, PlainSchedT<FFN_DOWN_FP8 != 0>, true>(lds, misc, S, E);
                GRID_BAR(6);
            }
        }
    }
    if (IN(11)) { PHASE_LOCALS if (NREP(11) > 1) route_phase(ap, lds, ctl + CW_CNT + 64 * 8, (unsigned char*)planes, G, c, tid, wid, lane);
        route_phase(ap, lds, ctl + CW_CNT, ws + WS_LIST, G, c, tid, wid, lane); GRID_BAR(11); }
    if (IN(12)) { PHASE_LOCALS
        MoeSched<true> S; S.mt = moe_tiles(ctl); S.so.init(S.mt.tstart[NE], 2 * FFE / 256, G, c); S.A = (const char*)(planes + 4 * PLANE); S.Bt = (const char*)(ws + WS_WM13); S.K = D / 2; S.bexp = (size_t)2 * FFE * D; S.rowtok = (const int*)(ws + WS_LIST); S.aux0 = (const float*)(ws + WS_LIST + 1024 * 1024); S.aux1 = nullptr;
        EpiG E{planes, (const float*)(ws + WS_LIST + 1024 * 1024)};
        for (int rep = 0; rep < NREP(12); ++rep) pg8::gemm_phase<EpiG, MoeSched<true>, true>(lds, misc, S, E);
        GRID_BAR(12);
    }
    if (IN(13)) { PHASE_LOCALS
        MoeSched<false> S; S.mt = moe_tiles(ctl); S.so.init(S.mt.tstart[NE], D / 256, G, c); S.A = (const char*)planes; S.Bt = (const char*)(ws + WS_WM2); S.K = FFE / 2; S.bexp = (size_t)D * FFE; S.rowtok = (const int*)(ws + WS_LIST); S.aux0 = (const float*)(ws + WS_LIST); S.aux1 = (const float*)(ws + WS_LIST + 512 * 1024);
        EpiH E{(bf16_t*)(ws + WS_WM13), (const int*)(ws + WS_LIST), (const float*)(ws + WS_LIST + 512 * 1024), S.mt};
        for (int rep = 0; rep < NREP(13); ++rep) pg8::gemm_phase<EpiH, MoeSched<false>, true>(lds, misc, S, E);
        GRID_BAR(13);
    }
    if (IN(14)) { PHASE_LOCALS
        const bf16_t* slots = (const bf16_t*)(ws + WS_WM13); const float* gfin = ap->in[I_GFINAL];
        f32x4 gv[4];
#pragma unroll
        for (int j = 0; j < 4; ++j) gv[j] = *((const f32x4*)gfin + lane + 64 * j);
        for (int rep = NREP(14) - 1; rep >= 0; --rep)
        for (int m = c * 8 + wid; m < T; m += G * 8) { const u32x2* xr = (const u32x2*)(xb + (size_t)m * D) + lane; f32x4* xo = (f32x4*)((rep ? (float*)planes : xw) + (size_t)m * D) + lane;
            const u32x2* s0 = (const u32x2*)(slots + (size_t)(2 * m) * D) + lane; const u32x2* s1 = (const u32x2*)(slots + (size_t)(2 * m + 1) * D) + lane;
            f32x4 v[4]; float s = 0.f;
#pragma unroll
            for (int j = 0; j < 4; ++j) { const u32x2 a = s0[64 * j], b = s1[64 * j], xv = xr[64 * j]; v[j] = (f32x4){bf_lo(xv.x), bf_hi(xv.x), bf_lo(xv.y), bf_hi(xv.y)} + (f32x4){bf_lo(a.x), bf_hi(a.x), bf_lo(a.y), bf_hi(a.y)} + (f32x4){bf_lo(b.x), bf_hi(b.x), bf_lo(b.y), bf_hi(b.y)};
                s += (v[j][0] * v[j][0] + v[j][1] * v[j][1]) + (v[j][2] * v[j][2] + v[j][3] * v[j][3]); }
            const float rs = __builtin_amdgcn_rsqf(wave_sum(s) * (1.0f / D) + EPS);
#pragma unroll
            for (int j = 0; j < 4; ++j) xo[64 * j] = v[j] * rs * gv[j]; }
    }
#undef IN
#undef GRID_BAR
#undef PHASE_LOCALS
}

extern "C" void kernel_launch(void* const* d_in, const int* in_sizes, int n_in, void* d_out, int out_size, void* d_ws, size_t ws_size, hipStream_t stream) {
    static int grid = 0;
    if (grid == 0) {
        if (n_in != 23 || in_sizes[0] != T * D || out_size != T * D || ws_size < WS_END) { fprintf(stderr, "kernel_launch: unexpected shapes (n_in %d, in0 %d, out %d, ws %zu < %zu); nothing launched\n", n_in, n_in > 0 ? in_sizes[0] : -1, out_size, ws_size, (size_t)WS_END); grid = -1; return; }
        int dev = 0, cus = 0, per_cu = 0;
        if (hipGetDevice(&dev) != hipSuccess || hipDeviceGetAttribute(&cus, hipDeviceAttributeMultiprocessorCount, dev) != hipSuccess) { grid = -1; return; }
        if (hipFuncSetAttribute((const void*)mk_fwd, hipFuncAttributeMaxDynamicSharedMemorySize, LDS_BYTES) != hipSuccess) { fprintf(stderr, "kernel_launch: hipFuncSetAttribute failed\n"); grid = -1; return; }
        if (hipOccupancyMaxActiveBlocksPerMultiprocessor(&per_cu, (const void*)mk_fwd, 512, LDS_BYTES) != hipSuccess || per_cu < 1) fprintf(stderr, "kernel_launch: note: occupancy query reports %d\n", per_cu);
        (void)hipGetLastError();
        grid = cus;
    }
    if (grid < 0) return;
    if (hipMemsetAsync((char*)d_ws + WS_CTL, 0, CTL_ZERO_BYTES, stream) != hipSuccess) return;
    Args a{};
    for (int i = 0; i < 23; ++i) a.in[i] = (const float*)d_in[i];
    a.out = (float*)d_out; a.ws = (unsigned char*)d_ws;
#if MK_N_LAUNCHES == 1
    a.ph_lo = 0; a.ph_hi = NPHASE;
    hipLaunchKernelGGL(mk_fwd, dim3(grid), dim3(512), LDS_BYTES, stream, a);
#else
    for (int p = 0; p < NPHASE; ++p) { a.ph_lo = p; a.ph_hi = p + 1; hipLaunchKernelGGL(mk_fwd, dim3(grid), dim3(512), LDS_BYTES, stream, a); }
#endif
}
```

```cpp
#include <hip/hip_runtime.h>
#include <cstdio>
#include <cstdint>
#include <utility>

#define LAS __attribute__((address_space(3)))
typedef unsigned short bf16_t;
typedef short bf16x8 __attribute__((ext_vector_type(8)));
typedef short bf16x4 __attribute__((ext_vector_type(4)));
typedef float f32x4 __attribute__((ext_vector_type(4)));
typedef float f32x2 __attribute__((ext_vector_type(2)));
typedef unsigned u32x4 __attribute__((ext_vector_type(4)));
typedef unsigned u32x2 __attribute__((ext_vector_type(2)));
typedef int i32x4 __attribute__((ext_vector_type(4)));
typedef int i32x8 __attribute__((ext_vector_type(8)));

#ifndef MK_N_LAUNCHES
#define MK_N_LAUNCHES 1
#endif
#ifndef MIX_FUSED
#define MIX_FUSED 1
#endif
#ifndef FILL_DELEGATE
#define FILL_DELEGATE 1
#endif
#ifndef FFN_DOWN_FP8
#define FFN_DOWN_FP8 1
#endif
#ifndef PH_MASK
#define PH_MASK 0x7fff
#endif
#define PH_MASK_ALL (PH_MASK == 0x7fff)

constexpr int T = 16384, D = 1024, SEQ = 4096, NIN = 6144, FFD = 2816, FFE = 3584, NE = 8, CK = 31, CHUNK = 128;
constexpr float EPS = 1e-6f;
constexpr float W13_SCALE = 32.0f, W2_SCALE = 64.0f;
constexpr int NPHASE = 15;

constexpr size_t MiB = 1u << 20;
constexpr size_t WS_CTL = 0, CTL_ZERO_BYTES = 65536;
constexpr size_t WS_WIN = 1 * MiB;
constexpr size_t WS_WCS = 25 * MiB;
constexpr size_t WS_WO = 33 * MiB;
constexpr size_t WS_WF13 = 37 * MiB;
constexpr size_t WS_WF2 = 48 * MiB;
constexpr size_t WS_SGW = 54 * MiB;
constexpr size_t WS_SSQ = 54 * MiB + 512 * 1024;
constexpr size_t WS_LIST = 55 * MiB;
constexpr size_t WS_CWT = 56 * MiB + 512 * 1024;
constexpr size_t WS_WM13 = 57 * MiB;
constexpr size_t WS_WM2 = 169 * MiB;
constexpr size_t WS_XB = 225 * MiB;
constexpr size_t WS_H = 257 * MiB;
constexpr size_t WS_END = 495 * MiB;
constexpr size_t PLANE = (size_t)T * D;
constexpr int CW_CNT = 64;
constexpr int CW_BAR = 4096;

constexpr int LDS_BYTES = 163840;
constexpr int MISC_OFF = 133632;
constexpr int M_TOK = 0;
constexpr int M_P = 1024;
constexpr int M_AUX = 5120;
constexpr int M_XB = 30176;
constexpr int M_PL = 13328;

__device__ __forceinline__ unsigned cvt_pk_bf16(float lo, float hi) { unsigned r; asm volatile("v_cvt_pk_bf16_f32 %0, %1, %2" : "=v"(r) : "v"(lo), "v"(hi)); return r; }
__device__ __forceinline__ float bf_lo(unsigned u) { return __uint_as_float(u << 16); }
__device__ __forceinline__ float bf_hi(unsigned u) { return __uint_as_float(u & 0xffff0000u); }
__device__ __forceinline__ float sigmoidf_(float x) { return __builtin_amdgcn_rcpf(1.0f + __builtin_amdgcn_exp2f(-1.44269504089f * x)); }
__device__ __forceinline__ float siluf_(float x) { return x * sigmoidf_(x); }
__device__ __forceinline__ float wave_sum(float v) {
#pragma unroll
    for (int o = 1; o < 64; o <<= 1) v += __shfl_xor(v, o);
    return v;
}
__device__ __forceinline__ f32x2 gelu_pk(f32x2 v) {
    const f32x2 av = __builtin_elementwise_abs(v), d = av * 0.2316418882f + 1.0f;
    f32x2 t; t.x = __builtin_amdgcn_rcpf(d.x); t.y = __builtin_amdgcn_rcpf(d.y);
    f32x2 q = t * 0.5307027145f + (-0.7265760135f); q = q * t + 0.7107068705f; q = q * t + (-0.142248368f); q = q * t + 0.127414796f; q = q * t;
    const f32x2 s = (v * v) * (-0.72134752044f);
    f32x2 e; e.x = __builtin_amdgcn_exp2f(s.x); e.y = __builtin_amdgcn_exp2f(s.y);
    return av * (0.5f - q * e) + v * 0.5f;
}
__device__ __forceinline__ f32x4 gelu4(f32x4 v) { const f32x2 a = gelu_pk((f32x2){v[0], v[1]}), b = gelu_pk((f32x2){v[2], v[3]}); return (f32x4){a.x, a.y, b.x, b.y}; }
__device__ __forceinline__ f32x4 swiglu4(f32x4 a, f32x4 b, float c, float k) { const f32x4 t = a * c; f32x4 e, r;
#pragma unroll
    for (int i = 0; i < 4; ++i) e[i] = __builtin_amdgcn_exp2f(t[i]);
    e = e + 1.0f;
#pragma unroll
    for (int i = 0; i < 4; ++i) r[i] = __builtin_amdgcn_rcpf(e[i]);
    return (a * b) * (r * k); }
__device__ __forceinline__ f32x4 glu4(f32x4 v, f32x4 g, float c, float rs) { const f32x4 t = g * c; f32x4 e, r;
#pragma unroll
    for (int i = 0; i < 4; ++i) e[i] = __builtin_amdgcn_exp2f(t[i]);
    e = e + 1.0f;
#pragma unroll
    for (int i = 0; i < 4; ++i) r[i] = __builtin_amdgcn_rcpf(e[i]);
    return v * (r * rs); }
__device__ __forceinline__ f32x4 sigm4(f32x4 v) { return (f32x4){sigmoidf_(v[0]), sigmoidf_(v[1]), sigmoidf_(v[2]), sigmoidf_(v[3])}; }
__device__ __forceinline__ u32x4 pack8(f32x4 a, f32x4 b) { u32x4 w; w.x = cvt_pk_bf16(a[0], a[1]); w.y = cvt_pk_bf16(a[2], a[3]); w.z = cvt_pk_bf16(b[0], b[1]); w.w = cvt_pk_bf16(b[2], b[3]); return w; }
__device__ __forceinline__ u32x2 pack8_fp8(f32x4 a, f32x4 b) { int w0 = 0, w1 = 0;
    w0 = __builtin_amdgcn_cvt_pk_fp8_f32(a[0], a[1], w0, false); w0 = __builtin_amdgcn_cvt_pk_fp8_f32(a[2], a[3], w0, true);
    w1 = __builtin_amdgcn_cvt_pk_fp8_f32(b[0], b[1], w1, false); w1 = __builtin_amdgcn_cvt_pk_fp8_f32(b[2], b[3], w1, true); return (u32x2){(unsigned)w0, (unsigned)w1}; }
__device__ __forceinline__ f32x4 unpk_lo(u32x4 w) { return (f32x4){bf_lo(w.x), bf_hi(w.x), bf_lo(w.y), bf_hi(w.y)}; }
__device__ __forceinline__ f32x4 unpk_hi(u32x4 w) { return (f32x4){bf_lo(w.z), bf_hi(w.z), bf_lo(w.w), bf_hi(w.w)}; }

namespace pg8 {
constexpr int BM = 256, BK = 64, HALF = 128, HTB = HALF * BK * 2, STAGE_BYTES = 8 * HTB, NXCD = 8, WGM = 8;
__host__ __device__ __forceinline__ int lds_byte(int r, int c) { const int st = (r >> 4) * 2 + (c >> 5), rr = r & 15, cc = c & 31, ob = rr * 64 + cc * 2; return st * 1024 + (ob ^ (((ob >> 9) & 1) << 5)); }
__host__ __device__ __forceinline__ void stage_rc(int b, int& R, int& C) { const int st = b / 1024, sb = b % 1024, swz = sb ^ (((sb >> 9) & 1) << 5); R = (st >> 1) * 16 + swz / 64; C = (st & 1) * 32 + (swz % 64) / 2; }
__host__ __device__ __forceinline__ int perm32(int rho) { const int n = rho >> 4, i = rho & 15; return 8 * (i >> 2) + 4 * n + (i & 3); }

struct Unit { int pm, pn, e, ti; };
struct StaticOrder {
    int nM, nN, nwg, G, c;
    __device__ __forceinline__ void init(int nM_, int nN_, int G_, int c_) { nM = nM_; nN = nN_; nwg = nM * nN; G = G_; c = c_; }
    __device__ __forceinline__ bool next(int i, Unit& u) const {
        const long L = (long)i * G + c; if (L >= nwg) return false;
        int wgid = (int)L; { const int q = nwg / NXCD, r = nwg % NXCD, xcd = wgid % NXCD, off = wgid / NXCD; wgid = (xcd < r ? xcd * (q + 1) : r * (q + 1) + (xcd - r) * q) + off; }
        const int nig = WGM * nN, gid = wgid / nig, fm = gid * WGM, gsz = (nM - fm) < WGM ? (nM - fm) : WGM;
        u.pm = fm + ((wgid % nig) % gsz); u.pn = (wgid % nig) / gsz; u.e = 0; u.ti = 0; return true;
    }
};

template <class Epi, class Sched, bool ALIGN_EPI>
__device__ __forceinline__ void gemm_phase(LAS unsigned char* lds, LAS unsigned char* misc, const Sched& S, const Epi& E) {
    constexpr bool GATHER = Sched::GATHER, FP8 = Sched::FP8;
    int tid_ = threadIdx.x; asm volatile("" : "+v"(tid_));
    const int tid = tid_, wid = __builtin_amdgcn_readfirstlane(tid >> 6), lane = tid & 63, wr = wid >> 2, wc = wid & 3, fr = lane & 15, fq = lane >> 4;
    const int K = S.K, nt = K / BK;
    unsigned voffA[2][2], voffB[2], colA2[2]; int rowA[2];
#pragma unroll
    for (int i = 0; i < 2; ++i) { int R, C; stage_rc(tid * 16 + i * 8192, R, C); const int Rb = (R & ~31) + perm32(R & 31);
        voffA[0][i] = voffA[1][i] = (unsigned)(R * K + C) * 2u; voffB[i] = (unsigned)(Rb * K + C) * 2u; rowA[i] = R; colA2[i] = (unsigned)C * 2u; }
    const size_t kstep = (size_t)(BK * 2);
    const size_t hstep = (size_t)HALF * K * 2;
    const size_t hstepA = GATHER ? (size_t)0 : hstep;
    const unsigned ldsw = (unsigned)wid * 1024u;
    const int aoff = FP8 ? lds_byte(wr * 64 + fr, (fq & 1) * 16) + (fq >> 1) * 1024 : lds_byte(wr * 64 + fr, fq * 8);
    const int boff = FP8 ? lds_byte(wc * 32 + fr, (fq & 1) * 16) + (fq >> 1) * 1024 : lds_byte(wc * 32 + fr, fq * 8);
    constexpr int KSTR = FP8 ? 16 : 1024;
#define PG8_SA(b, h) (((b) * 2 + (h)) * HTB)
#define PG8_SB(b, h) ((4 + (b) * 2 + (h)) * HTB)
#define PG8_STAGE(bufoff, gbase, voff) do { _Pragma("unroll") for (int _i = 0; _i < 2; ++_i) \
        __builtin_amdgcn_global_load_lds((const unsigned*)((const char*)(gbase) + (voff)[_i]), (LAS unsigned*)(lds + (bufoff) + ldsw + _i * 8192), 16, 0, 0); } while (0)
#define PG8_LDA(dst, b, h) do { _Pragma("unroll") for (int m = 0; m < 4; ++m) { const i32x4 f0_ = *(const LAS i32x4*)(lds + PG8_SA(b, h) + aoff + m * 2048), f1_ = *(const LAS i32x4*)(lds + PG8_SA(b, h) + aoff + m * 2048 + KSTR); dst[m] = __builtin_shufflevector(f0_, f1_, 0, 1, 2, 3, 4, 5, 6, 7); } } while (0)
#define PG8_LDB(dst, b, h) do { _Pragma("unroll") for (int n = 0; n < 2; ++n) { const i32x4 f0_ = *(const LAS i32x4*)(lds + PG8_SB(b, h) + boff + n * 2048), f1_ = *(const LAS i32x4*)(lds + PG8_SB(b, h) + boff + n * 2048 + KSTR); dst[n] = __builtin_shufflevector(f0_, f1_, 0, 1, 2, 3, 4, 5, 6, 7); } } while (0)
#define PG8_HALF(v, k) __builtin_bit_cast(bf16x8, __builtin_shufflevector(v, v, 4 * (k), 4 * (k) + 1, 4 * (k) + 2, 4 * (k) + 3))
#define PG8_MMA(ai, bj, At, Bt) do { __builtin_amdgcn_s_setprio(1); _Pragma("unroll") for (int m = 0; m < 4; ++m) _Pragma("unroll") for (int n = 0; n < 2; ++n) { \
        if constexpr (FP8) asm volatile("v_mfma_scale_f32_16x16x128_f8f6f4 %0, %1, %2, %0, %3, %3 op_sel_hi:[0,0,0]" : "+v"(acc[ai][bj][m][n]) : "v"(Bt[n]), "v"(At[m]), "v"(one_scale)); \
        else { acc[ai][bj][m][n] = __builtin_amdgcn_mfma_f32_16x16x32_bf16(PG8_HALF(Bt[n], 0), PG8_HALF(At[m], 0), acc[ai][bj][m][n], 0, 0, 0); \
               acc[ai][bj][m][n] = __builtin_amdgcn_mfma_f32_16x16x32_bf16(PG8_HALF(Bt[n], 1), PG8_HALF(At[m], 1), acc[ai][bj][m][n], 0, 0, 0); } } __builtin_amdgcn_s_setprio(0); } while (0)
#define PG8_WAIT_V(n) asm volatile("s_waitcnt vmcnt(" #n ")" ::: "memory")
#define PG8_WAIT_L(n) asm volatile("s_waitcnt lgkmcnt(" #n ")" ::: "memory")
#define PG8_BAR __builtin_amdgcn_s_barrier()
#define PG8_SCHED __builtin_amdgcn_sched_barrier(0)
    Unit cur, nxt; int ui = 0;
    if (!S.next(0, cur)) return;
    if constexpr (GATHER) {
#pragma unroll
        for (int h = 0; h < 2; ++h)
#pragma unroll
            for (int i = 0; i < 2; ++i) voffA[h][i] = (unsigned)S.tok(cur, h * HALF + rowA[i]) * (unsigned)(K * 2) + colA2[i];
    }
    f32x4 acc[2][2][4][2];
#pragma unroll
    for (int a = 0; a < 2; ++a)
#pragma unroll
        for (int b = 0; b < 2; ++b)
#pragma unroll
            for (int m = 0; m < 4; ++m)
#pragma unroll
                for (int n = 0; n < 2; ++n) acc[a][b][m][n] = (f32x4){0.f, 0.f, 0.f, 0.f};
    i32x8 At[4], B0[2], B1[2];
    const int one_scale = 0x7f7f7f7f;
    const char* cA = S.a_base(cur); const char* cB = S.b_base(cur);
    if (wid == 0) S.aux_dma(cur, 0, misc, lane);
    PG8_STAGE(PG8_SB(0, 0), cB, voffB); PG8_STAGE(PG8_SB(0, 1), cB + hstep, voffB); PG8_STAGE(PG8_SA(0, 0), cA, voffA[0]); PG8_STAGE(PG8_SA(0, 1), cA + hstepA, voffA[1]);
    if (wr == 1) PG8_BAR;
    PG8_WAIT_V(2); PG8_BAR;
    PG8_STAGE(PG8_SB(1, 0), cB + kstep, voffB); PG8_STAGE(PG8_SA(1, 0), cA + kstep, voffA[0]); PG8_STAGE(PG8_SB(1, 1), cB + hstep + kstep, voffB);
    PG8_WAIT_V(6); PG8_BAR;
    for (;;) {
        const bool has_next = S.next(ui + 1, nxt);
        const char* nA = has_next ? S.a_base(nxt) : cA; const char* nB = has_next ? S.b_base(nxt) : cB;
        unsigned nvoffA[2][2];
#pragma unroll
        for (int h = 0; h < 2; ++h)
#pragma unroll
            for (int i = 0; i < 2; ++i) nvoffA[h][i] = voffA[h][i];
        if constexpr (GATHER) {
            if (has_next && wid == 0) __builtin_amdgcn_global_load_lds((const unsigned*)(S.tok_ptr(nxt) + lane * 16), (LAS unsigned*)(misc + M_TOK), 16, 0, 0);
        }
        for (int t = 0; t < nt; t += 2) {
            const bool last = (t == nt - 2);
            if (t == 2 && has_next && wid == 0) S.aux_dma(nxt, ui + 1, misc, lane);
            const char* a1 = cA + (size_t)(t + 1) * kstep;
            const char* a2 = last ? nA : cA + (size_t)(t + 2) * kstep; const char* b2 = last ? nB : cB + (size_t)(t + 2) * kstep;
            const char* a3 = a2 + kstep; const char* b3 = b2 + kstep;
            unsigned va2[2][2];
            if constexpr (GATHER) {
                if (last && has_next) {
#pragma unroll
                    for (int h = 0; h < 2; ++h)
#pragma unroll
                        for (int i = 0; i < 2; ++i) { const unsigned tk = *(const LAS unsigned*)(misc + M_TOK + (h * HALF + rowA[i]) * 4); nvoffA[h][i] = ((tk >> 1) & (unsigned)(T - 1)) * (unsigned)(K * 2) + colA2[i]; }
                }
#pragma unroll
                for (int h = 0; h < 2; ++h)
#pragma unroll
                    for (int i = 0; i < 2; ++i) va2[h][i] = last ? nvoffA[h][i] : voffA[h][i];
            } else {
#pragma unroll
                for (int h = 0; h < 2; ++h)
#pragma unroll
                    for (int i = 0; i < 2; ++i) va2[h][i] = voffA[h][i];
            }
            PG8_LDB(B0, 0, 0); PG8_LDB(B1, 0, 1); PG8_SCHED; PG8_LDA(At, 0, 0); PG8_STAGE(PG8_SA(1, 1), a1 + hstepA, voffA[1]);
            PG8_WAIT_V(8); PG8_WAIT_L(0); PG8_BAR; PG8_MMA(0, 0, At, B0); PG8_MMA(0, 1, At, B1); PG8_BAR; PG8_SCHED;
            PG8_LDA(At, 0, 1); PG8_STAGE(PG8_SB(0, 0), b2, voffB); PG8_STAGE(PG8_SB(0, 1), b2 + hstep, voffB); PG8_STAGE(PG8_SA(0, 0), a2, va2[0]);
            PG8_WAIT_V(8); PG8_WAIT_L(0); PG8_BAR; PG8_MMA(1, 0, At, B0); PG8_MMA(1, 1, At, B1); PG8_BAR; PG8_SCHED;
            PG8_LDB(B0, 1, 0); PG8_LDB(B1, 1, 1); PG8_SCHED; PG8_LDA(At, 1, 0); PG8_STAGE(PG8_SA(0, 1), a2 + hstepA, va2[1]);
            PG8_WAIT_V(8); PG8_WAIT_L(0); PG8_BAR; PG8_MMA(0, 0, At, B0); PG8_MMA(0, 1, At, B1); PG8_BAR; PG8_SCHED;
            PG8_LDA(At, 1, 1); PG8_STAGE(PG8_SB(1, 0), b3, voffB); PG8_STAGE(PG8_SB(1, 1), b3 + hstep, voffB); PG8_STAGE(PG8_SA(1, 0), a3, va2[0]);
            PG8_WAIT_V(8); PG8_WAIT_L(0); PG8_BAR; PG8_MMA(1, 0, At, B0); PG8_MMA(1, 1, At, B1); PG8_BAR; PG8_SCHED;
        }
        if constexpr (FP8) asm volatile("s_nop 15\n\ts_nop 15" ::: "memory");
        if constexpr (ALIGN_EPI) { if (wr == 0) PG8_BAR; }
        E(acc, cur, wr, wc, fr, fq, misc, ui);
        if (!has_next) break;
        bool zero = true;
        if constexpr (Epi::KEEP_ACC) zero = !E.keep(cur);
        if (zero) {
#pragma unroll
        for (int a = 0; a < 2; ++a)
#pragma unroll
            for (int b = 0; b < 2; ++b)
#pragma unroll
                for (int m = 0; m < 4; ++m)
#pragma unroll
                    for (int n = 0; n < 2; ++n) acc[a][b][m][n] = (f32x4){0.f, 0.f, 0.f, 0.f};
        }
        cur = nxt; cA = nA; cB = nB; ++ui;
#pragma unroll
        for (int h = 0; h < 2; ++h)
#pragma unroll
            for (int i = 0; i < 2; ++i) voffA[h][i] = nvoffA[h][i];
        if constexpr (ALIGN_EPI) { if (wr == 1) PG8_BAR; }
    }
    PG8_WAIT_V(0);
    if constexpr (!ALIGN_EPI) { if (wr == 0) PG8_BAR; }
    PG8_BAR;
#undef PG8_SA
#undef PG8_SB
#undef PG8_STAGE
#undef PG8_LDA
#undef PG8_LDB
#undef PG8_HALF
#undef PG8_MMA
#undef PG8_WAIT_V
#undef PG8_WAIT_L
#undef PG8_BAR
#undef PG8_SCHED
}
}

template <bool F8_> struct PlainSchedT {
    static constexpr bool GATHER = false, FP8 = F8_;
    pg8::StaticOrder so; const char* A; const char* Bt; int K;
    __device__ __forceinline__ bool next(int i, pg8::Unit& u) const { return so.next(i, u); }
    __device__ __forceinline__ const char* a_base(const pg8::Unit& u) const { return A + (size_t)u.pm * 256 * K * 2; }
    __device__ __forceinline__ const char* b_base(const pg8::Unit& u) const { return Bt + (size_t)u.pn * 256 * K * 2; }
    __device__ __forceinline__ int tok(const pg8::Unit&, int) const { return 0; }
    __device__ __forceinline__ const char* tok_ptr(const pg8::Unit&) const { return nullptr; }
    __device__ __forceinline__ void aux_dma(const pg8::Unit&, int, LAS unsigned char*, int) const {}
};
typedef PlainSchedT<false> PlainSched;
struct PairSched {
    static constexpr bool GATHER = false, FP8 = false;
    pg8::StaticOrder so; const char* A; const char* Bt; int K;
    __device__ __forceinline__ bool next(int i, pg8::Unit& u) const { pg8::Unit b; if (!so.next(i >> 1, b)) return false; const int br = i & 1; u.pm = b.pm + 64 * br; u.pn = b.pn + 4 * br; u.e = 0; u.ti = 0; return true; }
    __device__ __forceinline__ const char* a_base(const pg8::Unit& u) const { return A + (size_t)u.pm * 256 * K * 2; }
    __device__ __forceinline__ const char* b_base(const pg8::Unit& u) const { return Bt + (size_t)u.pn * 256 * K * 2; }
    __device__ __forceinline__ int tok(const pg8::Unit&, int) const { return 0; }
    __device__ __forceinline__ const char* tok_ptr(const pg8::Unit&) const { return nullptr; }
    __device__ __forceinline__ void aux_dma(const pg8::Unit&, int, LAS unsigned char*, int) const {}
};
struct MoeTiles { int tstart[NE + 1]; int cnt[NE]; };
template <bool G_> struct MoeSched {
    static constexpr bool GATHER = G_, FP8 = true;
    pg8::StaticOrder so; const char* A; const char* Bt; int K; size_t bexp; MoeTiles mt; const int* rowtok;
    __device__ __forceinline__ bool next(int i, pg8::Unit& u) const { if (!so.next(i, u)) return false; int e = 0;
#pragma unroll
        for (int j = 1; j < NE; ++j) e += (u.pm >= mt.tstart[j]) ? 1 : 0;
        int ts = 0;
#pragma unroll
        for (int j = 1; j < NE; ++j) ts = (e == j) ? mt.tstart[j] : ts;
        u.e = e; u.ti = u.pm - ts; return true; }
    __device__ __forceinline__ const char* a_base(const pg8::Unit& u) const { return GATHER ? A : A + (size_t)u.pm * 256 * K * 2; }
    __device__ __forceinline__ const char* b_base(const pg8::Unit& u) const { return Bt + (size_t)u.e * bexp + (size_t)u.pn * 256 * K * 2; }
    __device__ __forceinline__ int tok(const pg8::Unit& u, int r) const { return (rowtok[u.e * 16384 + u.ti * 256 + r] >> 1) & (T - 1); }
    __device__ __forceinline__ const char* tok_ptr(const pg8::Unit& u) const { return (const char*)(rowtok + u.e * 16384 + u.ti * 256); }
    const float* aux0; const float* aux1;
    __device__ __forceinline__ void aux_dma(const pg8::Unit& u, int ui, LAS unsigned char* misc, int lane) const { const int lb = u.e * 16384 + u.ti * 256 + lane * 4; LAS unsigned char* t = misc + M_AUX + (ui & 1) * 2048;
        __builtin_amdgcn_global_load_lds((const unsigned*)(aux0 + lb), (LAS unsigned*)t, 16, 0, 0);
        if constexpr (!GATHER) __builtin_amdgcn_global_load_lds((const unsigned*)(aux1 + lb), (LAS unsigned*)(t + 1024), 16, 0, 0); }
};

__device__ __forceinline__ float row_rs(const float* ssq, int row) { return __builtin_amdgcn_rsqf((ssq[row] + ssq[T + row] + ssq[2 * T + row] + ssq[3 * T + row]) * (1.0f / D) + EPS); }

struct EpiA {   static constexpr bool KEEP_ACC = false;
    bf16_t* planes; const float* ssq;
    __device__ __forceinline__ void operator()(const f32x4 (&acc)[2][2][4][2], const pg8::Unit& u, int wr, int wc, int fr, int fq, LAS unsigned char* misc, int ui) const {
        const int row0 = u.pm * 256 + wr * 64 + fr; const LAS float* rst = (const LAS float*)(misc + M_AUX) + ui * 256 + wr * 64 + fr;
        if (u.pn < 8) {
            bf16_t* base = planes + (size_t)row0 * D + u.pn * 128 + wc * 32 + 8 * fq;
#pragma unroll
            for (int ai = 0; ai < 2; ++ai)
#pragma unroll
                for (int m = 0; m < 4; ++m) { const int r = ai * 128 + m * 16; const float rs = rst[r];
                    const float cc = rs * -1.44269504089f; const f32x4 o0 = glu4(acc[ai][0][m][0], acc[ai][1][m][0], cc, rs), o1 = glu4(acc[ai][0][m][1], acc[ai][1][m][1], cc, rs);
                    *(u32x4*)(base + (size_t)r * D) = pack8(o0, o1); }
        } else if (u.pn < 16) {
            const int p = (u.pn - 8) >> 2, colt = ((u.pn - 8) & 3) * 256;
            bf16_t* base = planes + (size_t)(1 + p) * PLANE + (size_t)row0 * D + colt + wc * 32 + 8 * fq;
#pragma unroll
            for (int ai = 0; ai < 2; ++ai)
#pragma unroll
                for (int m = 0; m < 4; ++m) { const int r = ai * 128 + m * 16; const float rs = rst[r];
#pragma unroll
                    for (int bj = 0; bj < 2; ++bj) *(u32x4*)(base + (size_t)r * D + bj * 128) = pack8(gelu4(acc[ai][bj][m][0] * rs), gelu4(acc[ai][bj][m][1] * rs)); }
        } else {
            bf16_t* base = planes + (size_t)3 * PLANE + (size_t)row0 * D + (u.pn - 16) * 128 + wc * 32 + 8 * fq;
#pragma unroll
            for (int ai = 0; ai < 2; ++ai)
#pragma unroll
                for (int m = 0; m < 4; ++m) { const int r = ai * 128 + m * 16; const float rs = rst[r] * -1.44269504089f; f32x4 rt[2], sb[2];
#pragma unroll
                    for (int n = 0; n < 2; ++n) { const f32x4 ga = acc[ai][0][m][n] * rs, gb = acc[ai][1][m][n] * rs;
                        f32x4 da, db, ra;
#pragma unroll
                        for (int i = 0; i < 4; ++i) { da[i] = __builtin_amdgcn_exp2f(ga[i]); db[i] = __builtin_amdgcn_exp2f(gb[i]); }
                        da = da + 1.0f; db = db + 1.0f;
#pragma unroll
                        for (int i = 0; i < 4; ++i) { ra[i] = __builtin_amdgcn_rcpf(da[i]); sb[n][i] = __builtin_amdgcn_rcpf(db[i]); }
                        rt[n] = db * ra; }
                    *(u32x4*)(base + (size_t)r * D) = pack8(rt[0], rt[1]); *(u32x4*)(base + PLANE + (size_t)r * D) = pack8(sb[0], sb[1]); }
        }
    }
};
struct EpiC {   static constexpr bool KEEP_ACC = true;
    bf16_t* mplane; const bf16_t* gates;
    __device__ __forceinline__ bool keep(const pg8::Unit& u) const { return (u.pn >> 2) == 0; }
    __device__ __forceinline__ void operator()(f32x4 (&acc)[2][2][4][2], const pg8::Unit& u, int wr, int wc, int fr, int fq, LAS unsigned char* misc, int ui) const {
        const int br = u.pn >> 2, pn = u.pn & 3, pm = u.pm - 64 * br;
        const size_t off0 = (size_t)(pm * 256 + wr * 64 + fr) * D + pn * 256 + wc * 32 + 8 * fq;
        const bf16_t* gp = gates + (size_t)br * PLANE + off0; bf16_t* mp = mplane + off0;
        u32x4 g[2][4][2];
#pragma unroll
        for (int ai = 0; ai < 2; ++ai)
#pragma unroll
            for (int m = 0; m < 4; ++m)
#pragma unroll
                for (int bj = 0; bj < 2; ++bj) g[ai][m][bj] = *(const u32x4*)(gp + (size_t)(ai * 128 + m * 16) * D + bj * 128);
#pragma unroll
        for (int ai = 0; ai < 2; ++ai)
#pragma unroll
            for (int m = 0; m < 4; ++m)
#pragma unroll
                for (int bj = 0; bj < 2; ++bj) { acc[ai][bj][m][0] *= unpk_lo(g[ai][m][bj]); acc[ai][bj][m][1] *= unpk_hi(g[ai][m][bj]); }
        if (br) {
#pragma unroll
            for (int ai = 0; ai < 2; ++ai)
#pragma unroll
                for (int m = 0; m < 4; ++m)
#pragma unroll
                    for (int bj = 0; bj < 2; ++bj) *(u32x4*)(mp + (size_t)(ai * 128 + m * 16) * D + bj * 128) = pack8(acc[ai][bj][m][0], acc[ai][bj][m][1]);
        }
    }
};
template <bool XF, bool ROUTE> struct EpiD {   static constexpr bool KEEP_ACC = false;
    const float* xf; bf16_t* xb; float* ssq; unsigned char* xq; float* plg; float scale;
    __device__ __forceinline__ void operator()(f32x4 (&acc)[2][2][4][2], const pg8::Unit& u, int wr, int wc, int fr, int fq, LAS unsigned char* misc, int ui) const {
        const size_t off0 = (size_t)(u.pm * 256 + wr * 64 + fr) * D + u.pn * 256 + wc * 32 + 8 * fq;
        LAS float* P = (LAS float*)(misc + M_P);
        if constexpr (XF) {
#pragma unroll
            for (int am = 0; am < 4; ++am) { const int ai = am >> 1, m0 = (am & 1) * 2; f32x4 xo[2][2][2];
#pragma unroll
                for (int m = 0; m < 2; ++m)
#pragma unroll
                    for (int bj = 0; bj < 2; ++bj) { const float* p = xf + off0 + (size_t)(ai * 128 + (m0 + m) * 16) * D + bj * 128; xo[m][bj][0] = *(const f32x4*)p; xo[m][bj][1] = *(const f32x4*)(p + 4); }
#pragma unroll
                for (int m = 0; m < 2; ++m)
#pragma unroll
                    for (int bj = 0; bj < 2; ++bj) { acc[ai][bj][m0 + m][0] = xo[m][bj][0] + acc[ai][bj][m0 + m][0] * scale; acc[ai][bj][m0 + m][1] = xo[m][bj][1] + acc[ai][bj][m0 + m][1] * scale;
                        asm volatile("" : "+v"(acc[ai][bj][m0 + m][0]), "+v"(acc[ai][bj][m0 + m][1]) :: "memory"); } }
        } else {
#pragma unroll
            for (int ai = 0; ai < 2; ++ai) { u32x4 xo[4][2];
#pragma unroll
                for (int m = 0; m < 4; ++m)
#pragma unroll
                    for (int bj = 0; bj < 2; ++bj) xo[m][bj] = *(const u32x4*)(xb + off0 + (size_t)(ai * 128 + m * 16) * D + bj * 128);
#pragma unroll
                for (int m = 0; m < 4; ++m)
#pragma unroll
                    for (int bj = 0; bj < 2; ++bj) { acc[ai][bj][m][0] = unpk_lo(xo[m][bj]) + acc[ai][bj][m][0] * scale; acc[ai][bj][m][1] = unpk_hi(xo[m][bj]) + acc[ai][bj][m][1] * scale;
                        asm volatile("" : "+v"(acc[ai][bj][m][0]), "+v"(acc[ai][bj][m][1]) :: "memory"); } }
        }
#pragma unroll
        for (int ai = 0; ai < 2; ++ai)
#pragma unroll
            for (int m = 0; m < 4; ++m) { float sq = 0.f;
#pragma unroll
                for (int bj = 0; bj < 2; ++bj) { const size_t o = off0 + (size_t)(ai * 128 + m * 16) * D + bj * 128;
                    const f32x4 v0 = acc[ai][bj][m][0], v1 = acc[ai][bj][m][1];
                    *(u32x4*)(xb + o) = pack8(v0, v1); if constexpr (ROUTE) *(u32x2*)(xq + o) = pack8_fp8(v0, v1);
                    sq += (v0[0] * v0[0] + v0[1] * v0[1]) + (v0[2] * v0[2] + v0[3] * v0[3]) + (v1[0] * v1[0] + v1[1] * v1[1]) + (v1[2] * v1[2] + v1[3] * v1[3]); }
                sq += __shfl_xor(sq, 16); sq += __shfl_xor(sq, 32);
                if (fq == 0) P[(ai * 128 + wr * 64 + m * 16 + fr) * 4 + wc] = sq; }
        asm volatile("s_waitcnt lgkmcnt(0)" ::: "memory"); __builtin_amdgcn_s_barrier(); asm volatile("" ::: "memory");
        const int tid = threadIdx.x;
        if (tid < 256) { const f32x4 p = *(const LAS f32x4*)(P + tid * 4); ssq[(size_t)u.pn * T + u.pm * 256 + tid] = (p[0] + p[1]) + (p[2] + p[3]); }
        asm volatile("s_waitcnt lgkmcnt(0)" ::: "memory"); __builtin_amdgcn_s_barrier(); asm volatile("" ::: "memory");
        if constexpr (ROUTE) {
            const LAS float* RW = (const LAS float*)(misc + M_AUX); LAS float* PL = (LAS float*)(misc + M_PL);
            const int cl = wc * 32 + 8 * fq;
#pragma unroll
            for (int hf = 0; hf < 2; ++hf) {
#pragma unroll
                for (int e4 = 0; e4 < 4; ++e4) { const int e = hf * 4 + e4; f32x4 w[2][2];
#pragma unroll
                    for (int bj = 0; bj < 2; ++bj) { w[bj][0] = *(const LAS f32x4*)(RW + e * 256 + bj * 128 + cl); w[bj][1] = *(const LAS f32x4*)(RW + e * 256 + bj * 128 + cl + 4); }
#pragma unroll
                    for (int ai = 0; ai < 2; ++ai)
#pragma unroll
                        for (int m = 0; m < 4; ++m) { f32x4 t = acc[ai][0][m][0] * w[0][0] + acc[ai][0][m][1] * w[0][1] + acc[ai][1][m][0] * w[1][0] + acc[ai][1][m][1] * w[1][1];
                            float d = (t[0] + t[1]) + (t[2] + t[3]); d += __shfl_xor(d, 16); d += __shfl_xor(d, 32);
                            if (fq == 0) PL[((ai * 128 + wr * 64 + m * 16 + fr) * 4 + wc) * 4 + e4] = d; } }
                asm volatile("s_waitcnt lgkmcnt(0)" ::: "memory"); __builtin_amdgcn_s_barrier(); asm volatile("" ::: "memory");
                if (tid < 256) { const LAS f32x4* q = (const LAS f32x4*)(PL + tid * 16); const f32x4 sum = (q[0] + q[1]) + (q[2] + q[3]);
                    *(f32x4*)(plg + ((size_t)u.pn * T + u.pm * 256 + tid) * 8 + hf * 4) = sum; }
                asm volatile("s_waitcnt lgkmcnt(0)" ::: "memory"); __builtin_amdgcn_s_barrier(); asm volatile("" ::: "memory");
            }
        }
    }
};
struct EpiE {   static constexpr bool KEEP_ACC = false;
    bf16_t* hid; const float* ssq; int ldh; int f8;
    __device__ __forceinline__ void operator()(const f32x4 (&acc)[2][2][4][2], const pg8::Unit& u, int wr, int wc, int fr, int fq, LAS unsigned char* misc, int ui) const {
        const int row0 = u.pm * 256 + wr * 64 + fr; const LAS float* rst = (const LAS float*)(misc + M_AUX) + ui * 256 + wr * 64 + fr;
        bf16_t* base = hid + (size_t)row0 * ldh + u.pn * 128 + wc * 32 + 8 * fq;
#pragma unroll
        for (int ai = 0; ai < 2; ++ai)
#pragma unroll
            for (int m = 0; m < 4; ++m) { const int r = ai * 128 + m * 16; const float rs = rst[r];
                f32x4 o[2];
#pragma unroll
                for (int n = 0; n < 2; ++n) o[n] = swiglu4(acc[ai][0][m][n], acc[ai][1][m][n], rs * -1.44269504089f, rs * rs);
                if (f8) *(u32x2*)((unsigned char*)hid + (size_t)(row0 + r) * ldh + u.pn * 128 + wc * 32 + 8 * fq) = pack8_fp8(o[0], o[1]); else *(u32x4*)(base + (size_t)r * ldh) = pack8(o[0], o[1]); }
    }
};
struct EpiG {   static constexpr bool KEEP_ACC = false;
    bf16_t* hid; const float* rowrs;
    __device__ __forceinline__ void operator()(const f32x4 (&acc)[2][2][4][2], const pg8::Unit& u, int wr, int wc, int fr, int fq, LAS unsigned char* misc, int ui) const {
        const int rl0 = wr * 64 + fr;
        unsigned char* base = (unsigned char*)hid + (size_t)(u.pm * 256 + rl0) * FFE + u.pn * 128 + wc * 32 + 8 * fq;
        const LAS float* rsp = (const LAS float*)(misc + M_AUX + (ui & 1) * 2048) + rl0;
#pragma unroll
        for (int ai = 0; ai < 2; ++ai)
#pragma unroll
            for (int m = 0; m < 4; ++m) { const int r = ai * 128 + m * 16; const float rs = rsp[r] * (1.0f / W13_SCALE);
                f32x4 o[2];
#pragma unroll
                for (int n = 0; n < 2; ++n) o[n] = swiglu4(acc[ai][0][m][n], acc[ai][1][m][n], rs * -1.44269504089f, rs * rs);
                *(u32x2*)(base + (size_t)r * FFE) = pack8_fp8(o[0], o[1]); }
    }
};
struct EpiH {   static constexpr bool KEEP_ACC = false;
    bf16_t* slots; const int* rowtok; const float* rowgate; MoeTiles mt;
    __device__ __forceinline__ void operator()(const f32x4 (&acc)[2][2][4][2], const pg8::Unit& u, int wr, int wc, int fr, int fq, LAS unsigned char* misc, int ui) const {
        int cnt = 0;
#pragma unroll
        for (int j = 0; j < NE; ++j) cnt = (u.e == j) ? mt.cnt[j] : cnt;
        const int nvalid = cnt - u.ti * 256, rl0 = wr * 64 + fr, col = u.pn * 256 + wc * 32 + 8 * fq;
        const LAS int* tst = (const LAS int*)(misc + M_AUX + (ui & 1) * 2048) + rl0; const LAS float* tgt = (const LAS float*)(misc + M_AUX + (ui & 1) * 2048 + 1024) + rl0;
#pragma unroll
        for (int ai = 0; ai < 2; ++ai)
#pragma unroll
            for (int m = 0; m < 4; ++m) { const int r = ai * 128 + m * 16;
                if (rl0 + r < nvalid) { const int ts = tst[r] & (2 * T - 1); const float g = tgt[r] * (1.0f / W2_SCALE);
                    bf16_t* o = slots + (size_t)ts * D + col;
#pragma unroll
                    for (int bj = 0; bj < 2; ++bj) *(u32x4*)(o + bj * 128) = pack8(acc[ai][bj][m][0] * g, acc[ai][bj][m][1] * g); } }
    }
};

template <class Sched> __device__ __forceinline__ void build_rs_table(const Sched& S, LAS unsigned char* misc, const float* ssq, int tid) {
    const int nu = (S.so.nwg - S.so.c + S.so.G - 1) / S.so.G;
    if (tid < 256 && nu > 0) { float q[6][4];
#pragma unroll
        for (int i = 0; i < 6; ++i) { pg8::Unit u; S.next(i < nu ? i : nu - 1, u); const float* p = ssq + u.pm * 256 + tid;
#pragma unroll
            for (int j = 0; j < 4; ++j) q[i][j] = p[j * T]; }
#pragma unroll
        for (int i = 0; i < 6; ++i) if (i < nu) ((LAS float*)(misc + M_AUX))[i * 256 + tid] = __builtin_amdgcn_rsqf(((q[i][0] + q[i][1]) + (q[i][2] + q[i][3])) * (1.0f / D) + EPS); }
    __syncthreads();
}

#define XB_TMO      128
#define XB_XCNT(j)  (256  + 64 * (j))
#define XB_XSUB(j)  (1280 + 64 * (j))
#define XB_XGEN(j)  (2304 + 64 * (j))
#define XB_TOP      3328
#define XB_TOPGEN   3392
#define XCD_BAR_WORDS 3456
#define XB_SPIN_CAP (1u << 18)
__device__ __forceinline__ unsigned xb_ld(unsigned* p)              { return __hip_atomic_load(p, __ATOMIC_RELAXED, __HIP_MEMORY_SCOPE_AGENT); }
__device__ __forceinline__ unsigned xb_add(unsigned* p, unsigned v) { return __hip_atomic_fetch_add(p, v, __ATOMIC_RELAXED, __HIP_MEMORY_SCOPE_AGENT); }
__device__ __forceinline__ unsigned xb_xcc_id() { return (unsigned)__builtin_amdgcn_s_getreg((3 << 11) | 20) & 0xFu; }
#define XB_SPIN(cond, bar) do { unsigned _sp = 0; while (cond) { __builtin_amdgcn_s_sleep(1); \
    if ((++_sp & 255u) == 0u) { if (xb_ld(&(bar)[XB_TMO])) break; if (_sp > XB_SPIN_CAP) { atomicAdd(&(bar)[XB_TMO], 1u); break; } } } } while (0)
struct XcdBarrier { unsigned* bar; unsigned x; volatile LAS unsigned* st; };
__device__ __forceinline__ XcdBarrier xcd_barrier_post(unsigned* bar, volatile LAS unsigned* st) {
    XcdBarrier b; b.bar = bar; b.x = xb_xcc_id(); b.st = st;
    if (threadIdx.x == 0) (void)xb_add(&bar[XB_XCNT(b.x)], 1u);
    return b;
}
__device__ __forceinline__ void xcd_barrier_complete(unsigned* bar, unsigned x, unsigned& nloc, unsigned& nx) {
    const unsigned G = gridDim.x * gridDim.y * gridDim.z;
    unsigned sum, cnt, mine, sp = 0u;
    for (;;) {
        sum = 0u; cnt = 0u; mine = 0u;
#pragma unroll
        for (unsigned j = 0; j < 16; ++j) { const unsigned c = xb_ld(&bar[XB_XCNT(j)]); sum += c; cnt += (c > 0u) ? 1u : 0u; mine = (j == x) ? c : mine; }
        if (sum == G) break;
        __builtin_amdgcn_s_sleep(1);
        if ((++sp & 255u) == 0u) { if (xb_ld(&bar[XB_TMO])) break; if (sp > XB_SPIN_CAP) { atomicAdd(&bar[XB_TMO], 1u); break; } }
    }
    nloc = mine > 0u ? mine : 1u; nx = cnt > 0u ? cnt : 1u;
}
__device__ __forceinline__ void xcd_barrier(const XcdBarrier& b) {
    asm volatile("s_waitcnt vmcnt(0)" ::: "memory");
    __syncthreads();
    if (threadIdx.x == 0) {
        unsigned* bar = b.bar;
        __builtin_amdgcn_s_waitcnt(0);
        unsigned nloc = b.st[0], nx = b.st[1];
        if (nloc == 0u) { xcd_barrier_complete(bar, b.x, nloc, nx); b.st[0] = nloc; b.st[1] = nx; }
        const unsigned old = xb_add(&bar[XB_XSUB(b.x)], 1u);
        const unsigned gen = old / nloc;
        if (old + 1u == (gen + 1u) * nloc) {
            __builtin_amdgcn_fence(__ATOMIC_RELEASE, "agent");
            asm volatile("s_waitcnt vmcnt(0)" ::: "memory");
            const unsigned og = xb_add(&bar[XB_TOP], 1u);
            const unsigned tg = og / nx;
            if (og + 1u == (tg + 1u) * nx) xb_add(&bar[XB_TOPGEN], 1u);
            else XB_SPIN(xb_ld(&bar[XB_TOPGEN]) == tg, bar);
            __builtin_amdgcn_fence(__ATOMIC_ACQUIRE, "agent");
            xb_add(&bar[XB_XGEN(b.x)], 1u);
            asm volatile("s_waitcnt vmcnt(0)" ::: "memory");
        } else {
            XB_SPIN(xb_ld(&bar[XB_XGEN(b.x)]) == gen, bar);
            __builtin_amdgcn_fence(__ATOMIC_ACQUIRE, "agent");
            asm volatile("s_waitcnt vmcnt(0)" ::: "memory");
        }
    }
    __syncthreads();
}

__device__ __forceinline__ void xpose_item(const float* W, int ldw, const float* g, bf16_t* WT, int Kd, int kb, int nb, int blk, int off, LAS float* scr, int lane) {
    const int k0 = 64 * kb, n0 = 64 * nb;
    const float* src = W + (size_t)k0 * ldw + n0 + lane;
    float v[64];
#pragma unroll
    for (int i = 0; i < 64; ++i) v[i] = __builtin_nontemporal_load(src + (size_t)i * ldw);
    if (g) {
#pragma unroll
        for (int i = 0; i < 64; ++i) scr[i * 65 + lane] = v[i] * g[k0 + i];
    } else {
#pragma unroll
        for (int i = 0; i < 64; ++i) scr[i * 65 + lane] = v[i];
    }
    asm volatile("s_waitcnt lgkmcnt(0)" ::: "memory");
    const int c = lane & 7;
#pragma unroll
    for (int j = 0; j < 8; ++j) { const int n = (lane >> 3) + 8 * j, nn = n0 + n; const LAS float* s = scr + (8 * c) * 65 + n;
        u32x4 o; o.x = cvt_pk_bf16(s[0 * 65], s[1 * 65]); o.y = cvt_pk_bf16(s[2 * 65], s[3 * 65]); o.z = cvt_pk_bf16(s[4 * 65], s[5 * 65]); o.w = cvt_pk_bf16(s[6 * 65], s[7 * 65]);
        *(u32x4*)(WT + (size_t)((nn >> 7) * blk + (nn & 127) + off) * Kd + k0 + 8 * c) = o; }
    asm volatile("s_waitcnt lgkmcnt(0)" ::: "memory");
}

__device__ __forceinline__ void xpose_item_fp8(const float* W, int ldw, const float* g, float sc, unsigned char* WT, int Kd, int kb, int nb, int blk, int off, LAS float* scr, int lane) {
    const int k0 = 64 * kb, n0 = 64 * nb;
    const float* src = W + (size_t)k0 * ldw + n0 + lane;
    float v[64];
#pragma unroll
    for (int i = 0; i < 64; ++i) v[i] = __builtin_nontemporal_load(src + (size_t)i * ldw);
    if (g) {
#pragma unroll
        for (int i = 0; i < 64; ++i) scr[i * 65 + lane] = v[i] * (g[k0 + i] * sc);
    } else {
#pragma unroll
        for (int i = 0; i < 64; ++i) scr[i * 65 + lane] = v[i] * sc;
    }
    asm volatile("s_waitcnt lgkmcnt(0)" ::: "memory");
    const int c = lane & 7;
#pragma unroll
    for (int j = 0; j < 8; ++j) { const int n = (lane >> 3) + 8 * j, nn = n0 + n; const LAS float* s = scr + (8 * c) * 65 + n;
        *(u32x2*)(WT + (size_t)((nn >> 7) * blk + (nn & 127) + off) * Kd + k0 + 8 * c) = pack8_fp8((f32x4){s[0 * 65], s[1 * 65], s[2 * 65], s[3 * 65]}, (f32x4){s[4 * 65], s[5 * 65], s[6 * 65], s[7 * 65]}); }
    asm volatile("s_waitcnt lgkmcnt(0)" ::: "memory");
}

struct Args { const float* in[23]; float* out; unsigned char* ws; int ph_lo, ph_hi; };
#define CAS __attribute__((address_space(4)))
typedef const CAS Args* ArgP;
__device__ __forceinline__ ArgP fresh_args() { unsigned long long p = (unsigned long long)__builtin_amdgcn_kernarg_segment_ptr(); asm volatile("" : "+s"(p)); return (ArgP)p; }
enum { I_X = 0, I_GMIX, I_WIN, I_CONVW, I_CONVB, I_CLNG, I_CLNB, I_WCO, I_SLNG, I_SLNB, I_SGW, I_SGB, I_WSO, I_WO, I_GFFN, I_F1, I_F3, I_F2, I_ROUTER, I_M1, I_M3, I_M2, I_GFINAL };


constexpr int IT_LAYER = 2304, IT_FFN = 2112, IT_EXP = 2688, IT_TOTAL = 2 * IT_LAYER + IT_FFN + NE * IT_EXP;
__device__ __forceinline__ void convert_item(ArgP ap, unsigned char* ws, int it, LAS float* scr, int lane) {
    int r = it;
    if (r < 2 * IT_LAYER) { const int l = r / IT_LAYER; r -= l * IT_LAYER;
        const float* win = ap->in[I_WIN] + (size_t)l * D * NIN; const float* gm = ap->in[I_GMIX] + l * D;
        bf16_t* wint = (bf16_t*)(ws + WS_WIN) + (size_t)l * NIN * D; bf16_t* wcs = (bf16_t*)(ws + WS_WCS) + (size_t)l * 2048 * D; bf16_t* wot = (bf16_t*)(ws + WS_WO) + (size_t)l * D * D;
        if (r < 256) { xpose_item(win, NIN, gm, wint, D, r >> 4, r & 15, 256, 0, scr, lane); return; } r -= 256;
        if (r < 256) { xpose_item(win + 1024, NIN, gm, wint, D, r >> 4, r & 15, 256, 128, scr, lane); return; } r -= 256;
        if (r < 512) { xpose_item(win + 2048, NIN, gm, wint, D, r >> 5, r & 31, 128, 2048, scr, lane); return; } r -= 512;
        if (r < 256) { xpose_item(win + 4096, NIN, gm, wint, D, r >> 4, r & 15, 256, 4096, scr, lane); return; } r -= 256;
        if (r < 256) { xpose_item(win + 5120, NIN, gm, wint, D, r >> 4, r & 15, 256, 4096 + 128, scr, lane); return; } r -= 256;
        if (r < 256) { xpose_item(ap->in[I_WCO] + (size_t)l * D * D, D, nullptr, wcs, D, r >> 4, r & 15, 128, 0, scr, lane); return; } r -= 256;
        if (r < 256) { xpose_item(ap->in[I_WSO] + (size_t)l * D * D, D, nullptr, wcs, D, r >> 4, r & 15, 128, 1024, scr, lane); return; } r -= 256;
        xpose_item(ap->in[I_WO] + (size_t)l * D * D, D, nullptr, wot, D, r >> 4, r & 15, 128, 0, scr, lane); return; }
    r -= 2 * IT_LAYER;
    if (r < IT_FFN) { const float* gf = ap->in[I_GFFN];
        if (r < 704) { xpose_item(ap->in[I_F1], FFD, gf, (bf16_t*)(ws + WS_WF13), D, r / 44, r % 44, 256, 0, scr, lane); return; } r -= 704;
        if (r < 704) { xpose_item(ap->in[I_F3], FFD, gf, (bf16_t*)(ws + WS_WF13), D, r / 44, r % 44, 256, 128, scr, lane); return; } r -= 704;
        if (FFN_DOWN_FP8) xpose_item_fp8(ap->in[I_F2], D, nullptr, W2_SCALE, ws + WS_WF2, FFD, r >> 4, r & 15, 128, 0, scr, lane);
        else xpose_item(ap->in[I_F2], D, nullptr, (bf16_t*)(ws + WS_WF2), FFD, r >> 4, r & 15, 128, 0, scr, lane);
        return; }
    r -= IT_FFN;
    { const int e = r / IT_EXP; r -= e * IT_EXP; const float* gf = ap->in[I_GFFN] + D;
        unsigned char* w13 = ws + WS_WM13 + (size_t)e * 2 * FFE * D; unsigned char* w2 = ws + WS_WM2 + (size_t)e * D * FFE;
        if (r < 896) { xpose_item_fp8(ap->in[I_M1] + (size_t)e * D * FFE, FFE, gf, W13_SCALE, w13, D, r / 56, r % 56, 256, 0, scr, lane); return; } r -= 896;
        if (r < 896) { xpose_item_fp8(ap->in[I_M3] + (size_t)e * D * FFE, FFE, gf, W13_SCALE, w13, D, r / 56, r % 56, 256, 128, scr, lane); return; } r -= 896;
        xpose_item_fp8(ap->in[I_M2] + (size_t)e * FFE * D, D, nullptr, W2_SCALE, w2, FFE, r >> 4, r & 15, 128, 0, scr, lane); }
}
constexpr int FL_WO0 = 256;
constexpr int FL_FFN = FL_WO0 + IT_FFN, FL_L1 = FL_FFN + IT_LAYER, FL_W13 = FL_L1 + NE * 1792, FL_TOTAL = FL_W13 + NE * 896;
__device__ __forceinline__ int filler_item(int i) {
    if (i < FL_WO0) return IT_LAYER - FL_WO0 + i;
    if (i < FL_FFN) return 2 * IT_LAYER + (i - FL_WO0);
    if (i < FL_L1) return IT_LAYER + (i - FL_FFN);
    if (i < FL_W13) { const int r = i - FL_L1, e = r / 1792; return 2 * IT_LAYER + IT_FFN + e * IT_EXP + (r - e * 1792); }
    const int r = i - FL_W13, e = r / 896; return 2 * IT_LAYER + IT_FFN + e * IT_EXP + 1792 + (r - e * 896);
}
__device__ __forceinline__ bool moe13_desc(ArgP ap, unsigned char* ws, int it, const float*& W, unsigned char*& WT, int& kb, int& nb, int& off) {
    int r = it - (2 * IT_LAYER + IT_FFN); if (r < 0) return false;
    const int e = r / IT_EXP; r -= e * IT_EXP; if (r >= 1792) return false;
    const int w3 = r >= 896 ? 1 : 0; r -= 896 * w3;
    W = ap->in[w3 ? I_M3 : I_M1] + (size_t)e * D * FFE; WT = ws + WS_WM13 + (size_t)e * 2 * FFE * D; kb = r / 56; nb = r % 56; off = 128 * w3; return true;
}
__device__ __forceinline__ void fp8_finish13(const float (&v)[64], const float* g, unsigned char* WT, int kb, int nb, int off, LAS float* scr, int lane) {
    const int k0 = 64 * kb, n0 = 64 * nb;
#pragma unroll
    for (int i = 0; i < 64; ++i) scr[i * 65 + lane] = v[i] * (g[k0 + i] * (float)W13_SCALE);
    asm volatile("s_waitcnt lgkmcnt(0)" ::: "memory");
    const int c = lane & 7;
#pragma unroll
    for (int j = 0; j < 8; ++j) { const int n = (lane >> 3) + 8 * j, nn = n0 + n; const LAS float* s = scr + (8 * c) * 65 + n;
        *(u32x2*)(WT + (size_t)((nn >> 7) * 256 + (nn & 127) + off) * D + k0 + 8 * c) = pack8_fp8((f32x4){s[0 * 65], s[1 * 65], s[2 * 65], s[3 * 65]}, (f32x4){s[4 * 65], s[5 * 65], s[6 * 65], s[7 * 65]}); }
    asm volatile("s_waitcnt lgkmcnt(0)" ::: "memory");
}
__device__ __forceinline__ void convert_pair13(ArgP ap, unsigned char* ws, int itA, int itB, LAS float* scr, int lane) {
    const float* Wa; const float* Wb; unsigned char* Ta; unsigned char* Tb; int kba, nba, offa, kbb, nbb, offb;
    if (!moe13_desc(ap, ws, itA, Wa, Ta, kba, nba, offa) || !moe13_desc(ap, ws, itB, Wb, Tb, kbb, nbb, offb)) { convert_item(ap, ws, itA, scr, lane); convert_item(ap, ws, itB, scr, lane); return; }
    const float* g = ap->in[I_GFFN] + D;
    const float* sa = Wa + (size_t)(64 * kba) * FFE + 64 * nba + lane; const float* sb = Wb + (size_t)(64 * kbb) * FFE + 64 * nbb + lane;
    float va[64], vb[64];
#pragma unroll
    for (int i = 0; i < 64; ++i) va[i] = __builtin_nontemporal_load(sa + (size_t)i * FFE);
#pragma unroll
    for (int i = 0; i < 64; ++i) vb[i] = __builtin_nontemporal_load(sb + (size_t)i * FFE);
    fp8_finish13(va, g, Ta, kba, nba, offa, scr, lane);
    fp8_finish13(vb, g, Tb, kbb, nbb, offb, scr, lane);
}
template <int PART> __device__ __forceinline__ void prologue_phase(ArgP ap, LAS unsigned char* lds, int G, int c, int tid, int wid, int lane) {
    unsigned char* ws = ap->ws;
    LAS float* scr = (LAS float*)(lds + wid * 16640);
    const int gw = c * 8 + wid, NGW = G * 8;
    constexpr int IT_LO = PART == 0 ? 0 : IT_LAYER - FL_WO0, IT_HI = PART == 0 ? IT_LAYER - FL_WO0 : IT_TOTAL;
    if constexpr (PART != 0) { for (int it = IT_LO + gw; it < IT_HI; it += NGW) convert_item(ap, ws, it, scr, lane); }
    if constexpr (PART == 0) {
    const float* x = ap->in[I_X]; bf16_t* xb = (bf16_t*)(ws + WS_XB); float* ssq = (float*)(ws + WS_SSQ);
    f32x4 xv[8][4];
#pragma unroll
    for (int j = 0; j < 8; ++j) { const int m = gw + NGW * j; const f32x4* xr = (const f32x4*)(x + (size_t)(m < T ? m : 0) * D) + lane;
#pragma unroll
        for (int q = 0; q < 4; ++q) xv[j][q] = __builtin_nontemporal_load(xr + 64 * q); }
    for (int it = IT_LO + gw; it < IT_HI; it += NGW) convert_item(ap, ws, it, scr, lane);
#pragma unroll
    for (int j = 0; j < 8; ++j) { const int m = gw + NGW * j; if (m < T) { u32x2* o8 = (u32x2*)(xb + (size_t)m * D) + lane; float s = 0.f;
#pragma unroll
        for (int q = 0; q < 4; ++q) { const f32x4 v = xv[j][q]; s += (v[0] * v[0] + v[1] * v[1]) + (v[2] * v[2] + v[3] * v[3]); u32x2 w; w.x = cvt_pk_bf16(v[0], v[1]); w.y = cvt_pk_bf16(v[2], v[3]); o8[64 * q] = w; }
        s = wave_sum(s);
        if (lane < 4) ssq[(size_t)lane * T + m] = lane == 0 ? s : 0.f; } }
    { for (int m = gw + NGW * 8; m < T; m += NGW) { const f32x4* xr = (const f32x4*)(x + (size_t)m * D) + lane; u32x2* o8 = (u32x2*)(xb + (size_t)m * D) + lane; float s = 0.f;
#pragma unroll
            for (int j = 0; j < 4; ++j) { const f32x4 v = xr[64 * j]; s += (v[0] * v[0] + v[1] * v[1]) + (v[2] * v[2] + v[3] * v[3]); u32x2 w; w.x = cvt_pk_bf16(v[0], v[1]); w.y = cvt_pk_bf16(v[2], v[3]); o8[64 * j] = w; }
            s = wave_sum(s);
            if (lane < 4) ssq[(size_t)lane * T + m] = lane == 0 ? s : 0.f; } }
    { const float* cwsrc = ap->in[I_CONVW]; float* o = (float*)(ws + WS_CWT);
        for (int i = c * 512 + tid; i < 2 * D * 32; i += G * 512) { const int k = i & 31, ch = (i >> 5) & (D - 1), l = i >> 15; o[i] = k < CK ? cwsrc[((size_t)l * CK + k) * D + ch] : 0.f; } }
    { const float* sw = ap->in[I_SGW]; bf16_t* o = (bf16_t*)(ws + WS_SGW);
        for (int i = c * 512 + tid; i < 2 * 8 * 128 * 16; i += G * 512) { const int t = (i >> 4) & 127, s0 = (i & 15) * 8; const f32x4 a = *(const f32x4*)(sw + (size_t)i * 8), b = *(const f32x4*)(sw + (size_t)i * 8 + 4);
            float v[8] = {a[0], a[1], a[2], a[3], b[0], b[1], b[2], b[3]};
#pragma unroll
            for (int j = 0; j < 8; ++j) v[j] = (s0 + j <= t) ? v[j] : 0.f;
            *(u32x4*)(o + (size_t)i * 8) = pack8((f32x4){v[0], v[1], v[2], v[3]}, (f32x4){v[4], v[5], v[6], v[7]}); } }
    }
}

constexpr int FILL_BARRIERS = 12, FILL_WAVES = 7, FILL_PER_WAVE = (FL_TOTAL + 256 * FILL_WAVES - 1) / (256 * FILL_WAVES);
__device__ __forceinline__ int fill_min(int seq) { return seq < 3 ? 2 * seq + 1 : (seq < 6 ? seq + 3 : seq + 4); }
static_assert(FILL_PER_WAVE == 15, "filler list");
__device__ __forceinline__ void xcd_barrier_fill(const XcdBarrier& b, ArgP ap, unsigned char* ws, LAS unsigned char* lds, volatile LAS unsigned* relw, int seq, int c, int wid, int lane, int& fdone) {
    asm volatile("s_waitcnt vmcnt(0)" ::: "memory");
    __syncthreads();
    if (wid == 0) {
        if (threadIdx.x == 0) {
            unsigned* bar = b.bar;
            __builtin_amdgcn_s_waitcnt(0);
            unsigned nloc = b.st[0], nx = b.st[1];
            if (nloc == 0u) { xcd_barrier_complete(bar, b.x, nloc, nx); b.st[0] = nloc; b.st[1] = nx; }
            const unsigned old = xb_add(&bar[XB_XSUB(b.x)], 1u);
            const unsigned gen = old / nloc;
            if (old + 1u == (gen + 1u) * nloc) {
                __builtin_amdgcn_fence(__ATOMIC_RELEASE, "agent");
                asm volatile("s_waitcnt vmcnt(0)" ::: "memory");
                const unsigned og = xb_add(&bar[XB_TOP], 1u);
                const unsigned tg = og / nx;
                if (og + 1u == (tg + 1u) * nx) xb_add(&bar[XB_TOPGEN], 1u);
                else XB_SPIN(xb_ld(&bar[XB_TOPGEN]) == tg, bar);
                __builtin_amdgcn_fence(__ATOMIC_ACQUIRE, "agent");
                xb_add(&bar[XB_XGEN(b.x)], 1u);
                asm volatile("s_waitcnt vmcnt(0)" ::: "memory");
            } else {
                XB_SPIN(xb_ld(&bar[XB_XGEN(b.x)]) == gen, bar);
                __builtin_amdgcn_fence(__ATOMIC_ACQUIRE, "agent");
                asm volatile("s_waitcnt vmcnt(0)" ::: "memory");
            }
            *relw = (unsigned)seq + 1u;
        }
    } else {
        LAS float* scr = (LAS float*)(lds + (wid - 1) * 16640);
        const int fw = c * FILL_WAVES + (wid - 1), need = fill_min(seq);
        int done = fdone;
        const bool deleg = FILL_DELEGATE && gridDim.x == 256;
        if (deleg && seq == 5 && c >= 128) {
            for (int jj = 0; jj < 2; ++jj) { const int j = 7 + jj, ip = fw - 128 * FILL_WAVES + 256 * FILL_WAVES * j;
                if (done <= j) { done = j + 1; convert_pair13(ap, ws, filler_item(fw + 256 * FILL_WAVES * j), filler_item(ip), scr, lane); }
                else convert_item(ap, ws, filler_item(ip), scr, lane); }
        }
        while (done < FILL_PER_WAVE) {
            if (deleg && c < 128 && (done == 7 || done == 8)) { ++done; continue; }
            if (done >= need && (unsigned)__builtin_amdgcn_readfirstlane((int)*relw) == (unsigned)seq + 1u) break;
            const int i = fw + 256 * FILL_WAVES * done;
            if (i < FL_TOTAL) convert_item(ap, ws, filler_item(i), scr, lane);
            ++done;
        }
        fdone = done;
    }
    asm volatile("s_waitcnt lgkmcnt(0)" ::: "memory"); __builtin_amdgcn_s_barrier(); asm volatile("" ::: "memory");
}

template <int J, int ROT> __device__ __forceinline__ void conv_row(f32x2 (&acc)[32], const f32x2 (&w)[32], LAS unsigned char* p) {
    constexpr int LO = J - 30 > 0 ? J - 30 : 0, HI = J < 31 ? J : 31, SLOT = (J + ROT) % 62;
    const unsigned raw = *(const LAS unsigned*)(p + SLOT * 2048); const f32x2 v = (f32x2){bf_lo(raw), bf_hi(raw)};
#pragma unroll
    for (int i = LO; i <= HI; ++i) acc[i] += w[J - i] * v;
    if constexpr ((J & 3) == 3) __builtin_amdgcn_sched_barrier(0);
}
template <int ROT, int... Js> __device__ __forceinline__ void conv_rows(f32x2 (&acc)[32], const f32x2 (&w)[32], LAS unsigned char* p, std::integer_sequence<int, Js...>) { (conv_row<Js, ROT>(acc, w, p), ...); }
__device__ __forceinline__ void conv_ln_store(LAS unsigned char* lds, f32x2 (&acc)[32], bf16_t* Cp, int t0, f32x2 g2, f32x2 b2, int tid, int wid, int lane) {
    float tot[2];
#pragma unroll
    for (int pass = 0; pass < 2; ++pass) {
        float val[32];
#pragma unroll
        for (int i = 0; i < 32; ++i) val[i] = pass == 0 ? acc[i].x + acc[i].y : acc[i].x * acc[i].x + acc[i].y * acc[i].y;
#pragma unroll
        for (int h = 16; h >= 1; h >>= 1) { const bool up = (lane & h) != 0;
#pragma unroll
            for (int k = 0; k < h; ++k) { const float lo = val[k], hi = val[k + h]; const float send = up ? lo : hi, keep = up ? hi : lo; val[k] = keep + __shfl_xor(send, h); } }
        tot[pass] = val[0] + __shfl_xor(val[0], 32);
    }
    LAS float* red = (LAS float*)(lds + 62 * 2048); LAS f32x2* stat = (LAS f32x2*)(lds + 62 * 2048 + 2048);
    red[wid * 64 + lane] = lane < 32 ? tot[0] : tot[1];
    asm volatile("s_waitcnt lgkmcnt(0)" ::: "memory"); __builtin_amdgcn_s_barrier(); asm volatile("" ::: "memory");
    if (tid < 32) { float s1 = 0.f, s2 = 0.f;
#pragma unroll
        for (int wv = 0; wv < 8; ++wv) { s1 += red[wv * 64 + tid]; s2 += red[wv * 64 + 32 + tid]; }
        const float mean = s1 * (1.0f / D), var = s2 * (1.0f / D) - mean * mean; stat[tid] = (f32x2){mean, __builtin_amdgcn_rsqf(var + EPS)}; }
    asm volatile("s_waitcnt lgkmcnt(0)" ::: "memory"); __builtin_amdgcn_s_barrier(); asm volatile("" ::: "memory");
    unsigned* outp = (unsigned*)(Cp + (size_t)t0 * D) + tid;
#pragma unroll
    for (int i = 0; i < 32; ++i) { const f32x2 st = stat[i]; const f32x2 y = (acc[i] - st.x) * st.y * g2 + b2; outp[(size_t)i * (D / 2)] = cvt_pk_bf16(siluf_(y.x), siluf_(y.y)); }
}
__device__ __forceinline__ void conv_load_w(f32x2 (&w)[32], const float* cw, int tid) {
    const f32x4* w0 = (const f32x4*)(cw + (size_t)(2 * tid) * 32); const f32x4* w1 = w0 + 8;
#pragma unroll
    for (int k4 = 0; k4 < 8; ++k4) { const f32x4 a = w0[k4], b = w1[k4];
#pragma unroll
        for (int i = 0; i < 4; ++i) w[4 * k4 + i] = (f32x2){a[i], b[i]}; }
}
__device__ __forceinline__ void conv_span(LAS unsigned char* lds, int span, const bf16_t* Ap, bf16_t* Cp, const float* cw, const float* cb, const float* lng, const float* lnb, int tid, int wid, int lane) {
    asm volatile("" : "+v"(tid));
    const int t0 = span * 64, s0 = t0 & (SEQ - 1);
    for (int q = wid; q < 124; q += 8) { const int j = q >> 1, hf = q & 1;
        if (s0 + j >= 30) __builtin_amdgcn_global_load_lds((const unsigned*)(Ap + (size_t)(t0 - 30 + j) * D + hf * 512 + lane * 8), (LAS unsigned*)(lds + j * 2048 + hf * 1024), 16, 0, 0);
        else *(LAS u32x4*)(lds + j * 2048 + hf * 1024 + lane * 16) = (u32x4){0u, 0u, 0u, 0u}; }
    f32x2 w[32];
    conv_load_w(w, cw, tid);
    const f32x2 bias = *(const f32x2*)(cb + 2 * tid), g2 = *(const f32x2*)(lng + 2 * tid), b2 = *(const f32x2*)(lnb + 2 * tid);
    asm volatile("s_waitcnt vmcnt(0) lgkmcnt(0)" ::: "memory"); __builtin_amdgcn_s_barrier(); asm volatile("" ::: "memory");
    f32x2 acc[32];
#pragma unroll
    for (int i = 0; i < 32; ++i) acc[i] = bias;
    conv_rows<0>(acc, w, lds + tid * 4, std::make_integer_sequence<int, 62>{});
    asm volatile("s_waitcnt lgkmcnt(0)" ::: "memory"); __builtin_amdgcn_s_barrier(); asm volatile("" ::: "memory");
    for (int q = wid; q < 64; q += 8) { const int j = q >> 1, hf = q & 1;
        __builtin_amdgcn_global_load_lds((const unsigned*)(Ap + (size_t)(t0 + 32 + j) * D + hf * 512 + lane * 8), (LAS unsigned*)(lds + j * 2048 + hf * 1024), 16, 0, 0); }
    conv_ln_store(lds, acc, Cp, t0, g2, b2, tid, wid, lane);
    f32x2 w2[32];
    conv_load_w(w2, cw, tid);
    asm volatile("s_waitcnt vmcnt(0) lgkmcnt(0)" ::: "memory"); __builtin_amdgcn_s_barrier(); asm volatile("" ::: "memory");
#pragma unroll
    for (int i = 0; i < 32; ++i) acc[i] = bias;
    conv_rows<32>(acc, w2, lds + tid * 4, std::make_integer_sequence<int, 62>{});
    conv_ln_store(lds, acc, Cp, t0 + 32, g2, b2, tid, wid, lane);
    asm volatile("s_waitcnt lgkmcnt(0)" ::: "memory"); __builtin_amdgcn_s_barrier(); asm volatile("" ::: "memory");
}

__device__ __forceinline__ unsigned off_b(unsigned row, unsigned ch) { return 256u * row + 16u * (ch ^ (((row & 3) << 2) | ((row >> 2) & 3))); }
__device__ __forceinline__ unsigned tr_read_addr_16(unsigned lane, unsigned cb, unsigned ks, unsigned t) { const unsigned g = lane >> 4, q = (lane & 15) >> 2, p = lane & 3; return off_b(32 * ks + 8 * g + 4 * t + q, 2 * cb + (p >> 1)) + 8 * (p & 1); }
__device__ __forceinline__ void sgu_load_gv(u32x4 (&raw)[4], const bf16_t* GV, int unit, int tid) {
    const int g = unit & 7, bn = unit >> 3, ch = tid & 15;
#pragma unroll
    for (int k = 0; k < 4; ++k) raw[k] = *(const u32x4*)(GV + (size_t)(bn * CHUNK + (tid >> 4) + 32 * k) * D + g * 128 + 8 * ch);
}
__device__ __forceinline__ void sgu_phase(LAS unsigned char* lds, int c, int G, const bf16_t* GV, const bf16_t* GU, bf16_t* Y, const float* lng, const float* lnb, const bf16_t* Wm, const float* sgb, int tid, int wid, int lane) {
    constexpr int NU = (T / CHUNK) * 8;
    const int fr = lane & 15, fq = lane >> 4, ch = tid & 15;
    u32x4 raw[4];
    if (c < NU) sgu_load_gv(raw, GV, c, tid);
    for (int unit = c; unit < NU; unit += G) {
        const int g = unit & 7, bn = unit >> 3, t0 = bn * CHUNK, c0 = g * 128, t = 16 * wid + fr;
        const f32x4 ga = *(const f32x4*)(lng + c0 + 8 * ch), gb = *(const f32x4*)(lng + c0 + 8 * ch + 4), ba = *(const f32x4*)(lnb + c0 + 8 * ch), bb = *(const f32x4*)(lnb + c0 + 8 * ch + 4);
        const bf16_t* wrow = Wm + ((size_t)g * 128 + t) * 128 + 8 * fq;
        bf16x8 bfrag[4];
#pragma unroll
        for (int ks = 0; ks < 4; ++ks) bfrag[ks] = *(const bf16x8*)(wrow + 32 * ks);
        u32x2 gu[8];
#pragma unroll
        for (int cb = 0; cb < 8; ++cb) gu[cb] = *(const u32x2*)(GU + (size_t)(t0 + t) * D + c0 + 16 * cb + 4 * fq);
        const float bias = sgb[g * 128 + t];
#pragma unroll
        for (int k = 0; k < 4; ++k) { const int s = (tid >> 4) + 32 * k; const f32x4 a = unpk_lo(raw[k]), b = unpk_hi(raw[k]);
            float sum = (a[0] + a[1]) + (a[2] + a[3]) + (b[0] + b[1]) + (b[2] + b[3]);
            float sq = (a[0] * a[0] + a[1] * a[1]) + (a[2] * a[2] + a[3] * a[3]) + (b[0] * b[0] + b[1] * b[1]) + (b[2] * b[2] + b[3] * b[3]);
#pragma unroll
            for (int o = 1; o < 16; o <<= 1) { sum += __shfl_xor(sum, o); sq += __shfl_xor(sq, o); }
            const float mean = sum * (1.0f / 128.0f), var = sq * (1.0f / 128.0f) - mean * mean, rstd = __builtin_amdgcn_rsqf(var + EPS);
            const f32x4 ya = (a - mean) * rstd * ga + ba, yb = (b - mean) * rstd * gb + bb;
            *(LAS u32x4*)(lds + off_b(s, ch)) = pack8(ya, yb); }
        if (unit + G < NU) sgu_load_gv(raw, GV, unit + G, tid);
        __syncthreads();
        f32x4 acc[8];
#pragma unroll
        for (int cb = 0; cb < 8; ++cb) acc[cb] = (f32x4){0.f, 0.f, 0.f, 0.f};
        const int nks = (wid >> 1) + 1;
#pragma unroll
        for (int ks = 0; ks < 4; ++ks) if (ks < nks) {
#pragma unroll
            for (int cb = 0; cb < 8; ++cb) { const bf16x4 lo = __builtin_amdgcn_ds_read_tr16_b64_v4i16((LAS bf16x4*)(lds + tr_read_addr_16(lane, cb, ks, 0))), hi = __builtin_amdgcn_ds_read_tr16_b64_v4i16((LAS bf16x4*)(lds + tr_read_addr_16(lane, cb, ks, 1)));
                const bf16x8 afrag = (bf16x8){lo[0], lo[1], lo[2], lo[3], hi[0], hi[1], hi[2], hi[3]};
                acc[cb] = __builtin_amdgcn_mfma_f32_16x16x32_bf16(afrag, bfrag[ks], acc[cb], 0, 0, 0); } }
#pragma unroll
        for (int cb = 0; cb < 8; ++cb) { u32x2 o; o.x = cvt_pk_bf16(bf_lo(gu[cb].x) * (acc[cb][0] + bias), bf_hi(gu[cb].x) * (acc[cb][1] + bias)); o.y = cvt_pk_bf16(bf_lo(gu[cb].y) * (acc[cb][2] + bias), bf_hi(gu[cb].y) * (acc[cb][3] + bias));
            *(u32x2*)(Y + (size_t)(t0 + t) * D + c0 + 16 * cb + 4 * fq) = o; }
        __syncthreads();
    }
}

struct SguRegs { u32x4 raw[4]; };
__device__ __forceinline__ void sgu_issue(SguRegs& r, int unit, const bf16_t* GV, const bf16_t* GU, int tid, int wid, int lane) {
    const int fr = lane & 15, fq = lane >> 4, g = unit & 7, bn = unit >> 3, t0 = bn * CHUNK, c0 = g * 128, t = 16 * wid + fr;
    sgu_load_gv(r.raw, GV, unit, tid); (void)GU; (void)fq; (void)t0; (void)c0; (void)t;
}
__device__ __forceinline__ void sgu_finish(LAS unsigned char* lds, const SguRegs& r, int unit, const bf16_t* GU, bf16_t* Y, const float* lng, const float* lnb, const bf16_t* Wm, const float* sgb, int tid, int wid, int lane) {
    const int fr = lane & 15, fq = lane >> 4, ch = tid & 15, g = unit & 7, bn = unit >> 3, t0 = bn * CHUNK, c0 = g * 128, t = 16 * wid + fr;
    const f32x4 ga = *(const f32x4*)(lng + c0 + 8 * ch), gb = *(const f32x4*)(lng + c0 + 8 * ch + 4), ba = *(const f32x4*)(lnb + c0 + 8 * ch), bb = *(const f32x4*)(lnb + c0 + 8 * ch + 4);
    const bf16_t* wrow = Wm + ((size_t)g * 128 + t) * 128 + 8 * fq;
    bf16x8 bfrag[4];
#pragma unroll
    for (int ks = 0; ks < 4; ++ks) bfrag[ks] = *(const bf16x8*)(wrow + 32 * ks);
    const float bias = sgb[g * 128 + t];
    u32x2 gu[8];
#pragma unroll
    for (int cb = 0; cb < 8; ++cb) gu[cb] = *(const u32x2*)(GU + (size_t)(t0 + t) * D + c0 + 16 * cb + 4 * fq);
#pragma unroll
    for (int k = 0; k < 4; ++k) { const int sr = (tid >> 4) + 32 * k; const f32x4 a = unpk_lo(r.raw[k]), b = unpk_hi(r.raw[k]);
        float sum = (a[0] + a[1]) + (a[2] + a[3]) + (b[0] + b[1]) + (b[2] + b[3]);
        float sq = (a[0] * a[0] + a[1] * a[1]) + (a[2] * a[2] + a[3] * a[3]) + (b[0] * b[0] + b[1] * b[1]) + (b[2] * b[2] + b[3] * b[3]);
#pragma unroll
        for (int o = 1; o < 16; o <<= 1) { sum += __shfl_xor(sum, o); sq += __shfl_xor(sq, o); }
        const float mean = sum * (1.0f / 128.0f), var = sq * (1.0f / 128.0f) - mean * mean, rstd = __builtin_amdgcn_rsqf(var + EPS);
        const f32x4 ya = (a - mean) * rstd * ga + ba, yb = (b - mean) * rstd * gb + bb;
        *(LAS u32x4*)(lds + off_b(sr, ch)) = pack8(ya, yb); }
    asm volatile("s_waitcnt lgkmcnt(0)" ::: "memory"); __builtin_amdgcn_s_barrier(); asm volatile("" ::: "memory");
    f32x4 acc[8];
#pragma unroll
    for (int cb = 0; cb < 8; ++cb) acc[cb] = (f32x4){0.f, 0.f, 0.f, 0.f};
    const int nks = (wid >> 1) + 1;
#pragma unroll
    for (int ks = 0; ks < 4; ++ks) if (ks < nks) {
#pragma unroll
        for (int cb = 0; cb < 8; ++cb) { const bf16x4 lo = __builtin_amdgcn_ds_read_tr16_b64_v4i16((LAS bf16x4*)(lds + tr_read_addr_16(lane, cb, ks, 0))), hi = __builtin_amdgcn_ds_read_tr16_b64_v4i16((LAS bf16x4*)(lds + tr_read_addr_16(lane, cb, ks, 1)));
            const bf16x8 afrag = (bf16x8){lo[0], lo[1], lo[2], lo[3], hi[0], hi[1], hi[2], hi[3]};
            acc[cb] = __builtin_amdgcn_mfma_f32_16x16x32_bf16(afrag, bfrag[ks], acc[cb], 0, 0, 0); } }
#pragma unroll
    for (int cb = 0; cb < 8; ++cb) { u32x2 o; o.x = cvt_pk_bf16(bf_lo(gu[cb].x) * (acc[cb][0] + bias), bf_hi(gu[cb].x) * (acc[cb][1] + bias)); o.y = cvt_pk_bf16(bf_lo(gu[cb].y) * (acc[cb][2] + bias), bf_hi(gu[cb].y) * (acc[cb][3] + bias));
        *(u32x2*)(Y + (size_t)(t0 + t) * D + c0 + 16 * cb + 4 * fq) = o; }
    asm volatile("s_waitcnt lgkmcnt(0)" ::: "memory"); __builtin_amdgcn_s_barrier(); asm volatile("" ::: "memory");
}
__device__ __forceinline__ void mix_fused(LAS unsigned char* lds, int span, int u0, int G, const bf16_t* Ap, bf16_t* Cp, const float* cw, const float* cb, const float* lng, const float* lnb,
                                          const bf16_t* GV, const bf16_t* GU, bf16_t* Y, const float* slng, const float* slnb, const bf16_t* Wm, const float* sgb, int tid, int wid, int lane) {
    constexpr int NU = (T / CHUNK) * 8;
    LAS unsigned char* cl = lds + 32768;
    SguRegs ra;
    int unit = u0;
    sgu_issue(ra, unit, GV, GU, tid, wid, lane);
    const int t0 = span * 64, s0 = t0 & (SEQ - 1);
    for (int q = wid; q < 124; q += 8) { const int j = q >> 1, hf = q & 1;
        if (s0 + j >= 30) __builtin_amdgcn_global_load_lds((const unsigned*)(Ap + (size_t)(t0 - 30 + j) * D + hf * 512 + lane * 8), (LAS unsigned*)(cl + j * 2048 + hf * 1024), 16, 0, 0);
        else *(LAS u32x4*)(cl + j * 2048 + hf * 1024 + lane * 16) = (u32x4){0u, 0u, 0u, 0u}; }
    f32x2 acc[32];
    { f32x2 w[32];
      conv_load_w(w, cw, tid);
      const f32x2 bias = *(const f32x2*)(cb + 2 * tid);
      asm volatile("s_waitcnt vmcnt(0) lgkmcnt(0)" ::: "memory"); __builtin_amdgcn_s_barrier(); asm volatile("" ::: "memory");
#pragma unroll
      for (int i = 0; i < 32; ++i) acc[i] = bias;
      conv_rows<0>(acc, w, cl + tid * 4, std::make_integer_sequence<int, 62>{}); }
    asm volatile("s_waitcnt lgkmcnt(0)" ::: "memory"); __builtin_amdgcn_s_barrier(); asm volatile("" ::: "memory");
    for (int q = wid; q < 64; q += 8) { const int j = q >> 1, hf = q & 1;
        __builtin_amdgcn_global_load_lds((const unsigned*)(Ap + (size_t)(t0 + 32 + j) * D + hf * 512 + lane * 8), (LAS unsigned*)(cl + j * 2048 + hf * 1024), 16, 0, 0); }
    __builtin_amdgcn_sched_barrier(0); conv_ln_store(cl, acc, Cp, t0, *(const f32x2*)(lng + 2 * tid), *(const f32x2*)(lnb + 2 * tid), tid, wid, lane);
    __builtin_amdgcn_sched_barrier(0); sgu_finish(lds, ra, unit, GU, Y, slng, slnb, Wm, sgb, tid, wid, lane);
    unit += G;
    { f32x2 w2[32];
      asm volatile("s_waitcnt vmcnt(0) lgkmcnt(0)" ::: "memory"); __builtin_amdgcn_s_barrier(); asm volatile("" ::: "memory");
      conv_load_w(w2, cw, tid);
      const f32x2 bias = *(const f32x2*)(cb + 2 * tid);
      if (unit < NU) sgu_issue(ra, unit, GV, GU, tid, wid, lane);
#pragma unroll
      for (int i = 0; i < 32; ++i) acc[i] = bias;
      conv_rows<32>(acc, w2, cl + tid * 4, std::make_integer_sequence<int, 62>{}); }
    __builtin_amdgcn_sched_barrier(0); conv_ln_store(cl, acc, Cp, t0 + 32, *(const f32x2*)(lng + 2 * tid), *(const f32x2*)(lnb + 2 * tid), tid, wid, lane);
    __builtin_amdgcn_sched_barrier(0);
    SguRegs rb;
    const int u1 = unit, u2 = unit + G, u3 = unit + 2 * G;
    if (u2 < NU) sgu_issue(rb, u2, GV, GU, tid, wid, lane);
    __builtin_amdgcn_sched_barrier(0); if (u1 < NU) sgu_finish(lds, ra, u1, GU, Y, slng, slnb, Wm, sgb, tid, wid, lane);
    __builtin_amdgcn_sched_barrier(0); if (u3 < NU) sgu_issue(ra, u3, GV, GU, tid, wid, lane);
    __builtin_amdgcn_sched_barrier(0); if (u2 < NU) sgu_finish(lds, rb, u2, GU, Y, slng, slnb, Wm, sgb, tid, wid, lane);
    __builtin_amdgcn_sched_barrier(0); if (u3 < NU) sgu_finish(lds, ra, u3, GU, Y, slng, slnb, Wm, sgb, tid, wid, lane);
}

__device__ __forceinline__ void route_phase(ArgP ap, LAS unsigned char* lds, unsigned* cntw, unsigned char* listb, int G, int c, int tid, int wid, int lane) {
    const float* plg = (const float*)((const bf16_t*)(ap->ws + WS_H) + 5 * PLANE); const float* ssq = (const float*)(ap->ws + WS_SSQ);
    int* rowtok = (int*)listb; float* rowgate = (float*)(listb + 512 * 1024); float* rowrs = (float*)(listb + 1024 * 1024);
    LAS int* s_lcnt = (LAS int*)lds; LAS int* s_gb = s_lcnt + 8;
    for (int blk = c; blk < T / 64; blk += G) {
        if (tid < 8) s_lcnt[tid] = 0;
        __syncthreads();
        int r0 = 0, r1 = 0, e0 = 0, e1 = 0; float w0 = 0.f, rs = 0.f; const int tok = blk * 64 + tid;
        if (tid < 64) { f32x4 la = (f32x4){0.f, 0.f, 0.f, 0.f}, lb = la; float ss = 0.f;
#pragma unroll
            for (int pn = 0; pn < 4; ++pn) { const float* q = plg + ((size_t)pn * T + tok) * 8; la += *(const f32x4*)q; lb += *(const f32x4*)(q + 4); ss += ssq[(size_t)pn * T + tok]; }
            rs = __builtin_amdgcn_rsqf(ss * (1.0f / D) + EPS);
            const float dot[8] = {la[0], la[1], la[2], la[3], lb[0], lb[1], lb[2], lb[3]};
            float bv = dot[0] * rs; int bi = 0;
#pragma unroll
            for (int e = 1; e < 8; ++e) { const float l = dot[e] * rs; if (l > bv) { bv = l; bi = e; } }
            float sv = -3.0e38f; int si = 0;
#pragma unroll
            for (int e = 0; e < 8; ++e) { const float l = dot[e] * rs; if (e != bi && l > sv) { sv = l; si = e; } }
            w0 = 1.0f / (1.0f + __expf(sv - bv)); e0 = bi; e1 = si;
            r0 = __hip_atomic_fetch_add(s_lcnt + e0, 1, __ATOMIC_RELAXED, __HIP_MEMORY_SCOPE_WORKGROUP); r1 = __hip_atomic_fetch_add(s_lcnt + e1, 1, __ATOMIC_RELAXED, __HIP_MEMORY_SCOPE_WORKGROUP); }
        __syncthreads();
        if (tid < 8) s_gb[tid] = (int)__hip_atomic_fetch_add(cntw + 64 * tid, (unsigned)s_lcnt[tid], __ATOMIC_RELAXED, __HIP_MEMORY_SCOPE_AGENT);
        __syncthreads();
        if (tid < 64) { const int i0 = e0 * 16384 + s_gb[e0] + r0, i1 = e1 * 16384 + s_gb[e1] + r1;
            rowtok[i0] = 2 * tok; rowgate[i0] = w0; rowrs[i0] = rs;
            rowtok[i1] = 2 * tok + 1; rowgate[i1] = 1.0f - w0; rowrs[i1] = rs; }
        __syncthreads();
    }
}
__device__ __forceinline__ MoeTiles moe_tiles(unsigned* ctl) {
    MoeTiles mt; int acc = 0;
#pragma unroll
    for (int e = 0; e < NE; ++e) { int cn = (int)__hip_atomic_load(ctl + CW_CNT + 64 * e, __ATOMIC_RELAXED, __HIP_MEMORY_SCOPE_AGENT); cn = cn < 0 ? 0 : (cn > T ? T : cn);
        cn = __builtin_amdgcn_readfirstlane(cn); mt.cnt[e] = cn; mt.tstart[e] = acc; acc += (cn + 255) >> 8; }
    mt.tstart[NE] = acc; return mt;
}

__global__ void __launch_bounds__(512, 2) mk_fwd(Args args) {
    extern __shared__ __attribute__((aligned(16))) unsigned char lds_raw[];
    LAS unsigned char* lds = (LAS unsigned char*)lds_raw;
    LAS unsigned char* misc = lds + MISC_OFF;
    const int G = gridDim.x, c = blockIdx.x;
    if (threadIdx.x < 4) ((LAS unsigned*)(misc + M_XB))[threadIdx.x] = 0u;
    __syncthreads();
    const int lo = args.ph_lo, hi = args.ph_hi;
    int fdone = 0;
    const bool fill = (lo == 0 && hi == NPHASE && G == 256 && PH_MASK_ALL);
    XcdBarrier bar; bar.bar = (unsigned*)(args.ws + WS_CTL) + CW_BAR; bar.x = 0; bar.st = (volatile LAS unsigned*)(misc + M_XB);
    if (hi - lo > 1) bar = xcd_barrier_post((unsigned*)(args.ws + WS_CTL) + CW_BAR, (volatile LAS unsigned*)(misc + M_XB));
#define IN(k) (((PH_MASK >> ((k) >= 7 && (k) <= 10 ? (k) - 6 : (k))) & 1) && lo <= (k) && (k) < hi)
#define GRID_BAR(k) do { if (IN(k) && IN((k) + 1)) { XcdBarrier b_ = bar; asm volatile("" : "+s"(b_.bar), "+s"(b_.x)); if (fill && (k) < FILL_BARRIERS) xcd_barrier_fill(b_, ap, ws, lds, (volatile LAS unsigned*)(misc + M_XB + 8), (k), c, wid, lane, fdone); else xcd_barrier(b_); if (DBL_BAR) xcd_barrier(b_); } } while (0)
#ifndef REP_MASK
#define REP_MASK 0
#endif
#ifndef DBL_BAR
#define DBL_BAR 0
#endif
#define NREP(k) (((REP_MASK >> (k)) & 1) ? 2 : 1)
#define PHASE_LOCALS ArgP ap = fresh_args(); unsigned char* ws = ap->ws; int tid = threadIdx.x; asm volatile("" : "+v"(tid)); const int lane = tid & 63, wid = __builtin_amdgcn_readfirstlane(tid >> 6); \
    bf16_t* planes = (bf16_t*)(ws + WS_H); bf16_t* xb = (bf16_t*)(ws + WS_XB); float* ssq = (float*)(ws + WS_SSQ); float* xw = ap->out; unsigned* ctl = (unsigned*)(ws + WS_CTL); \
    (void)lane; (void)wid; (void)planes; (void)xb; (void)ssq; (void)xw; (void)ctl;

    if (IN(0)) { PHASE_LOCALS for (int rep = 0; rep < NREP(0); ++rep) { prologue_phase<0>(ap, lds, G, c, tid, wid, lane); if (!fill) prologue_phase<1>(ap, lds, G, c, tid, wid, lane); __syncthreads(); } GRID_BAR(0); }

#pragma unroll
    for (int l = 0; l < 2; ++l) {
        const int pb = 1 + 6 * l;
        if (IN(pb)) { PHASE_LOCALS
            PlainSched S; S.so.init(T / 256, NIN / 256, G, c); S.A = (const char*)xb; S.Bt = (const char*)((bf16_t*)(ws + WS_WIN) + (size_t)l * NIN * D); S.K = D;
            EpiA E{planes, ssq};
            build_rs_table(S, misc, ssq, tid);
            for (int rep = 0; rep < NREP(1); ++rep) pg8::gemm_phase<EpiA, PlainSched, true>(lds, misc, S, E);
            GRID_BAR(pb);
        }
        if (IN(pb + 1)) { PHASE_LOCALS
            const float* cw = (const float*)(ws + WS_CWT) + (size_t)l * D * 32;
#define PHASE_B_BODY \
            for (int sp = c; sp < T / 64; sp += G) conv_span(lds, sp, planes, planes + 5 * PLANE, cw, ap->in[I_CONVB] + l * D, ap->in[I_CLNG] + l * D, ap->in[I_CLNB] + l * D, tid, wid, lane); \
            sgu_phase(lds, c, G, planes + 2 * PLANE, planes + 1 * PLANE, planes + 6 * PLANE, ap->in[I_SLNG] + l * D, ap->in[I_SLNB] + l * D, \
                      (const bf16_t*)(ws + WS_SGW) + (size_t)l * 8 * 128 * 128, ap->in[I_SGB] + l * 8 * 128, tid, wid, lane); \

#if MIX_FUSED && !((REP_MASK >> 2) & 1) && !defined(REP_CONV) && !defined(REP_SGU)
            if (G * 64 == T) mix_fused(lds, c, c, G, planes, planes + 5 * PLANE, cw, ap->in[I_CONVB] + l * D, ap->in[I_CLNG] + l * D, ap->in[I_CLNB] + l * D, planes + 2 * PLANE, planes + 1 * PLANE, planes + 6 * PLANE,
                                       ap->in[I_SLNG] + l * D, ap->in[I_SLNB] + l * D, (const bf16_t*)(ws + WS_SGW) + (size_t)l * 8 * 128 * 128, ap->in[I_SGB] + l * 8 * 128, tid, wid, lane);
            else { PHASE_B_BODY }
#else
            PHASE_B_BODY
#endif
#if (REP_MASK >> 2) & 1
            PHASE_B_BODY
#endif
#undef PHASE_B_BODY
#ifdef REP_CONV
            for (int sp = c; sp < T / 64; sp += G) conv_span(lds, sp, planes, planes + 5 * PLANE, cw, ap->in[I_CONVB] + l * D, ap->in[I_CLNG] + l * D, ap->in[I_CLNB] + l * D, tid, wid, lane);
#endif
#ifdef REP_SGU
            sgu_phase(lds, c, G, planes + 2 * PLANE, planes + 1 * PLANE, planes + 6 * PLANE, ap->in[I_SLNG] + l * D, ap->in[I_SLNB] + l * D, (const bf16_t*)(ws + WS_SGW) + (size_t)l * 8 * 128 * 128, ap->in[I_SGB] + l * 8 * 128, tid, wid, lane);
#endif
            GRID_BAR(pb + 1);
        }
        if (IN(pb + 2)) { PHASE_LOCALS
            PairSched S; S.so.init(T / 256, D / 256, G, c); S.A = (const char*)(planes + 5 * PLANE); S.Bt = (const char*)((bf16_t*)(ws + WS_WCS) + (size_t)l * 2048 * D); S.K = D;
            EpiC E{planes, planes + 3 * PLANE};
            for (int rep = 0; rep < NREP(3); ++rep) pg8::gemm_phase<EpiC, PairSched, true>(lds, misc, S, E);
            GRID_BAR(pb + 2);
        }
        if (IN(pb + 3)) { PHASE_LOCALS
            PlainSched S; S.so.init(T / 256, D / 256, G, c); S.A = (const char*)planes; S.Bt = (const char*)((bf16_t*)(ws + WS_WO) + (size_t)l * D * D); S.K = D;
            if (l == 1) { pg8::Unit u0; if (S.next(0, u0)) { const float* gf = ap->in[I_GFFN] + D; const float* rt = ap->in[I_ROUTER];
                    for (int i = tid; i < 8 * 256; i += 512) { const int e = i >> 8, cg = u0.pn * 256 + (i & 255); ((LAS float*)(misc + M_AUX))[i] = gf[cg] * rt[(size_t)cg * 8 + e]; } }
                __syncthreads(); }
            if (l == 0) {
                EpiD<true, false> E{ap->in[I_X], xb, ssq, nullptr, nullptr, 1.0f};
                if (NREP(4) > 1) { EpiD<true, false> E0{E.xf, planes + 3 * PLANE, (float*)(planes + 5 * PLANE), nullptr, nullptr, 1.0f}; pg8::gemm_phase<EpiD<true, false>, PlainSched, true>(lds, misc, S, E0); }
                pg8::gemm_phase<EpiD<true, false>, PlainSched, true>(lds, misc, S, E);
            } else {
                EpiD<false, true> E{nullptr, xb, ssq, (unsigned char*)(planes + 4 * PLANE), (float*)(planes + 5 * PLANE), 1.0f};
                pg8::gemm_phase<EpiD<false, true>, PlainSched, true>(lds, misc, S, E);
            }
            GRID_BAR(pb + 3);
        }
        if (l == 0) {
            if (IN(5)) { PHASE_LOCALS
                PlainSched S; S.so.init(T / 256, 2 * FFD / 256, G, c); S.A = (const char*)xb; S.Bt = (const char*)(ws + WS_WF13); S.K = D;
                EpiE E{planes, ssq, FFD, FFN_DOWN_FP8};
                build_rs_table(S, misc, ssq, tid);
                for (int rep = 0; rep < NREP(5); ++rep) pg8::gemm_phase<EpiE, PlainSched, true>(lds, misc, S, E);
                GRID_BAR(5);
            }
            if (IN(6)) { PHASE_LOCALS
                PlainSchedT<FFN_DOWN_FP8 != 0> S; S.so.init(T / 256, D / 256, G, c); S.A = (const char*)planes; S.Bt = (const char*)(ws + WS_WF2); S.K = FFN_DOWN_FP8 ? FFD / 2 : FFD;
                EpiD<false, false> E{nullptr, xb, ssq, nullptr, nullptr, FFN_DOWN_FP8 ? 1.0f / W2_SCALE : 1.0f};
                if (NREP(6) > 1) { EpiD<false, false> E0{nullptr, planes + 5 * PLANE, (float*)(planes + 6 * PLANE), nullptr, nullptr, FFN_DOWN_FP8 ? 1.0f / W2_SCALE : 1.0f}; pg8::gemm_phase<EpiD<false, false>, PlainSchedT<FFN_DOWN_FP8 != 0>, true>(lds, misc, S, E0); }
                pg8::gemm_phase<EpiD<false, false>, PlainSchedT<FFN_DOWN_FP8 != 0>, true>(lds, misc, S, E);
                GRID_BAR(6);
            }
        }
    }
    if (IN(11)) { PHASE_LOCALS if (NREP(11) > 1) route_phase(ap, lds, ctl + CW_CNT + 64 * 8, (unsigned char*)planes, G, c, tid, wid, lane);
        route_phase(ap, lds, ctl + CW_CNT, ws + WS_LIST, G, c, tid, wid, lane); GRID_BAR(11); }
    if (IN(12)) { PHASE_LOCALS
        MoeSched<true> S; S.mt = moe_tiles(ctl); S.so.init(S.mt.tstart[NE], 2 * FFE / 256, G, c); S.A = (const char*)(planes + 4 * PLANE); S.Bt = (const char*)(ws + WS_WM13); S.K = D / 2; S.bexp = (size_t)2 * FFE * D; S.rowtok = (const int*)(ws + WS_LIST); S.aux0 = (const float*)(ws + WS_LIST + 1024 * 1024); S.aux1 = nullptr;
        EpiG E{planes, (const float*)(ws + WS_LIST + 1024 * 1024)};
        for (int rep = 0; rep < NREP(12); ++rep) pg8::gemm_phase<EpiG, MoeSched<true>, true>(lds, misc, S, E);
        GRID_BAR(12);
    }
    if (IN(13)) { PHASE_LOCALS
        MoeSched<false> S; S.mt = moe_tiles(ctl); S.so.init(S.mt.tstart[NE], D / 256, G, c); S.A = (const char*)planes; S.Bt = (const char*)(ws + WS_WM2); S.K = FFE / 2; S.bexp = (size_t)D * FFE; S.rowtok = (const int*)(ws + WS_LIST); S.aux0 = (const float*)(ws + WS_LIST); S.aux1 = (const float*)(ws + WS_LIST + 512 * 1024);
        EpiH E{(bf16_t*)(ws + WS_WM13), (const int*)(ws + WS_LIST), (const float*)(ws + WS_LIST + 512 * 1024), S.mt};
        for (int rep = 0; rep < NREP(13); ++rep) pg8::gemm_phase<EpiH, MoeSched<false>, true>(lds, misc, S, E);
        GRID_BAR(13);
    }
    if (IN(14)) { PHASE_LOCALS
        const bf16_t* slots = (const bf16_t*)(ws + WS_WM13); const float* gfin = ap->in[I_GFINAL];
        f32x4 gv[4];
#pragma unroll
        for (int j = 0; j < 4; ++j) gv[j] = *((const f32x4*)gfin + lane + 64 * j);
        for (int rep = NREP(14) - 1; rep >= 0; --rep)
        for (int m = c * 8 + wid; m < T; m += G * 8) { const u32x2* xr = (const u32x2*)(xb + (size_t)m * D) + lane; f32x4* xo = (f32x4*)((rep ? (float*)planes : xw) + (size_t)m * D) + lane;
            const u32x2* s0 = (const u32x2*)(slots + (size_t)(2 * m) * D) + lane; const u32x2* s1 = (const u32x2*)(slots + (size_t)(2 * m + 1) * D) + lane;
            f32x4 v[4]; float s = 0.f;
#pragma unroll
            for (int j = 0; j < 4; ++j) { const u32x2 a = s0[64 * j], b = s1[64 * j], xv = xr[64 * j]; v[j] = (f32x4){bf_lo(xv.x), bf_hi(xv.x), bf_lo(xv.y), bf_hi(xv.y)} + (f32x4){bf_lo(a.x), bf_hi(a.x), bf_lo(a.y), bf_hi(a.y)} + (f32x4){bf_lo(b.x), bf_hi(b.x), bf_lo(b.y), bf_hi(b.y)};
                s += (v[j][0] * v[j][0] + v[j][1] * v[j][1]) + (v[j][2] * v[j][2] + v[j][3] * v[j][3]); }
            const float rs = __builtin_amdgcn_rsqf(wave_sum(s) * (1.0f / D) + EPS);
#pragma unroll
            for (int j = 0; j < 4; ++j) xo[64 * j] = v[j] * rs * gv[j]; }
    }
#undef IN
#undef GRID_BAR
#undef PHASE_LOCALS
}

extern "C" void kernel_launch(void* const* d_in, const int* in_sizes, int n_in, void* d_out, int out_size, void* d_ws, size_t ws_size, hipStream_t stream) {
    static int grid = 0;
    if (grid == 0) {
        if (n_in != 23 || in_sizes[0] != T * D || out_size != T * D || ws_size < WS_END) { fprintf(stderr, "kernel_launch: unexpected shapes (n_in %d, in0 %d, out %d, ws %zu < %zu); nothing launched\n", n_in, n_in > 0 ? in_sizes[0] : -1, out_size, ws_size, (size_t)WS_END); grid = -1; return; }
        int dev = 0, cus = 0, per_cu = 0;
        if (hipGetDevice(&dev) != hipSuccess || hipDeviceGetAttribute(&cus, hipDeviceAttributeMultiprocessorCount, dev) != hipSuccess) { grid = -1; return; }
        if (hipFuncSetAttribute((const void*)mk_fwd, hipFuncAttributeMaxDynamicSharedMemorySize, LDS_BYTES) != hipSuccess) { fprintf(stderr, "kernel_launch: hipFuncSetAttribute failed\n"); grid = -1; return; }
        if (hipOccupancyMaxActiveBlocksPerMultiprocessor(&per_cu, (const void*)mk_fwd, 512, LDS_BYTES) != hipSuccess || per_cu < 1) fprintf(stderr, "kernel_launch: note: occupancy query reports %d\n", per_cu);
        (void)hipGetLastError();
        grid = cus;
    }
    if (grid < 0) return;
    if (hipMemsetAsync((char*)d_ws + WS_CTL, 0, CTL_ZERO_BYTES, stream) != hipSuccess) return;
    Args a{};
    for (int i = 0; i < 23; ++i) a.in[i] = (const float*)d_in[i];
    a.out = (float*)d_out; a.ws = (unsigned char*)d_ws;
#if MK_N_LAUNCHES == 1
    a.ph_lo = 0; a.ph_hi = NPHASE;
    hipLaunchKernelGGL(mk_fwd, dim3(grid), dim3(512), LDS_BYTES, stream, a);
#else
    for (int p = 0; p < NPHASE; ++p) { a.ph_lo = p; a.ph_hi = p + 1; hipLaunchKernelGGL(mk_fwd, dim3(grid), dim3(512), LDS_BYTES, stream, a); }
#endif
}
```

```cpp
#include <hip/hip_runtime.h>
#include <cstdio>
#include <cstdint>
#include <utility>

#define LAS __attribute__((address_space(3)))
typedef unsigned short bf16_t;
typedef short bf16x8 __attribute__((ext_vector_type(8)));
typedef short bf16x4 __attribute__((ext_vector_type(4)));
typedef float f32x4 __attribute__((ext_vector_type(4)));
typedef float f32x2 __attribute__((ext_vector_type(2)));
typedef unsigned u32x4 __attribute__((ext_vector_type(4)));
typedef unsigned u32x2 __attribute__((ext_vector_type(2)));
typedef int i32x4 __attribute__((ext_vector_type(4)));
typedef int i32x8 __attribute__((ext_vector_type(8)));

#ifndef MK_N_LAUNCHES
#define MK_N_LAUNCHES 1
#endif
#ifndef MIX_FUSED
#define MIX_FUSED 1
#endif
#ifndef FILL_DELEGATE
#define FILL_DELEGATE 1
#endif
#ifndef PAIR_REQUIRED
#define PAIR_REQUIRED 1
#endif
#ifndef FFN_DOWN_FP8
#define FFN_DOWN_FP8 1
#endif
#ifndef PH_MASK
#define PH_MASK 0x7fff
#endif
#define PH_MASK_ALL (PH_MASK == 0x7fff)

constexpr int T = 16384, D = 1024, SEQ = 4096, NIN = 6144, FFD = 2816, FFE = 3584, NE = 8, CK = 31, CHUNK = 128;
constexpr float EPS = 1e-6f;
constexpr float W13_SCALE = 32.0f, W2_SCALE = 64.0f;
constexpr int NPHASE = 15;

constexpr size_t MiB = 1u << 20;
constexpr size_t WS_CTL = 0, CTL_ZERO_BYTES = 65536;
constexpr size_t WS_WIN = 1 * MiB;
constexpr size_t WS_WCS = 25 * MiB;
constexpr size_t WS_WO = 33 * MiB;
constexpr size_t WS_WF13 = 37 * MiB;
constexpr size_t WS_WF2 = 48 * MiB;
constexpr size_t WS_SGW = 54 * MiB;
constexpr size_t WS_SSQ = 54 * MiB + 512 * 1024;
constexpr size_t WS_LIST = 55 * MiB;
constexpr size_t WS_CWT = 56 * MiB + 512 * 1024;
constexpr size_t WS_WM13 = 57 * MiB;
constexpr size_t WS_WM2 = 169 * MiB;
constexpr size_t WS_XB = 225 * MiB;
constexpr size_t WS_H = 257 * MiB;
constexpr size_t WS_END = 495 * MiB;
constexpr size_t PLANE = (size_t)T * D;
constexpr int CW_CNT = 64;
constexpr int CW_BAR = 4096;

constexpr int LDS_BYTES = 163840;
constexpr int MISC_OFF = 133632;
constexpr int M_TOK = 0;
constexpr int M_P = 1024;
constexpr int M_AUX = 5120;
constexpr int M_XB = 30176;
constexpr int M_PL = 13328;

__device__ __forceinline__ unsigned cvt_pk_bf16(float lo, float hi) { unsigned r; asm volatile("v_cvt_pk_bf16_f32 %0, %1, %2" : "=v"(r) : "v"(lo), "v"(hi)); return r; }
__device__ __forceinline__ float bf_lo(unsigned u) { return __uint_as_float(u << 16); }
__device__ __forceinline__ float bf_hi(unsigned u) { return __uint_as_float(u & 0xffff0000u); }
__device__ __forceinline__ float sigmoidf_(float x) { return __builtin_amdgcn_rcpf(1.0f + __builtin_amdgcn_exp2f(-1.44269504089f * x)); }
__device__ __forceinline__ float siluf_(float x) { return x * sigmoidf_(x); }
__device__ __forceinline__ float wave_sum(float v) {
#pragma unroll
    for (int o = 1; o < 64; o <<= 1) v += __shfl_xor(v, o);
    return v;
}
__device__ __forceinline__ f32x2 gelu_pk(f32x2 v) {
    const f32x2 av = __builtin_elementwise_abs(v), d = av * 0.2316418882f + 1.0f;
    f32x2 t; t.x = __builtin_amdgcn_rcpf(d.x); t.y = __builtin_amdgcn_rcpf(d.y);
    f32x2 q = t * 0.5307027145f + (-0.7265760135f); q = q * t + 0.7107068705f; q = q * t + (-0.142248368f); q = q * t + 0.127414796f; q = q * t;
    const f32x2 s = (v * v) * (-0.72134752044f);
    f32x2 e; e.x = __builtin_amdgcn_exp2f(s.x); e.y = __builtin_amdgcn_exp2f(s.y);
    return av * (0.5f - q * e) + v * 0.5f;
}
__device__ __forceinline__ f32x4 gelu4(f32x4 v) { const f32x2 a = gelu_pk((f32x2){v[0], v[1]}), b = gelu_pk((f32x2){v[2], v[3]}); return (f32x4){a.x, a.y, b.x, b.y}; }
__device__ __forceinline__ f32x4 swiglu4(f32x4 a, f32x4 b, float c, float k) { const f32x4 t = a * c; f32x4 e, r;
#pragma unroll
    for (int i = 0; i < 4; ++i) e[i] = __builtin_amdgcn_exp2f(t[i]);
    e = e + 1.0f;
#pragma unroll
    for (int i = 0; i < 4; ++i) r[i] = __builtin_amdgcn_rcpf(e[i]);
    return (a * b) * (r * k); }
__device__ __forceinline__ f32x4 glu4(f32x4 v, f32x4 g, float c, float rs) { const f32x4 t = g * c; f32x4 e, r;
#pragma unroll
    for (int i = 0; i < 4; ++i) e[i] = __builtin_amdgcn_exp2f(t[i]);
    e = e + 1.0f;
#pragma unroll
    for (int i = 0; i < 4; ++i) r[i] = __builtin_amdgcn_rcpf(e[i]);
    return v * (r * rs); }
__device__ __forceinline__ f32x4 sigm4(f32x4 v) { return (f32x4){sigmoidf_(v[0]), sigmoidf_(v[1]), sigmoidf_(v[2]), sigmoidf_(v[3])}; }
__device__ __forceinline__ u32x4 pack8(f32x4 a, f32x4 b) { u32x4 w; w.x = cvt_pk_bf16(a[0], a[1]); w.y = cvt_pk_bf16(a[2], a[3]); w.z = cvt_pk_bf16(b[0], b[1]); w.w = cvt_pk_bf16(b[2], b[3]); return w; }
__device__ __forceinline__ u32x2 pack8_fp8(f32x4 a, f32x4 b) { int w0 = 0, w1 = 0;
    w0 = __builtin_amdgcn_cvt_pk_fp8_f32(a[0], a[1], w0, false); w0 = __builtin_amdgcn_cvt_pk_fp8_f32(a[2], a[3], w0, true);
    w1 = __builtin_amdgcn_cvt_pk_fp8_f32(b[0], b[1], w1, false); w1 = __builtin_amdgcn_cvt_pk_fp8_f32(b[2], b[3], w1, true); return (u32x2){(unsigned)w0, (unsigned)w1}; }
__device__ __forceinline__ f32x4 unpk_lo(u32x4 w) { return (f32x4){bf_lo(w.x), bf_hi(w.x), bf_lo(w.y), bf_hi(w.y)}; }
__device__ __forceinline__ f32x4 unpk_hi(u32x4 w) { return (f32x4){bf_lo(w.z), bf_hi(w.z), bf_lo(w.w), bf_hi(w.w)}; }

namespace pg8 {
constexpr int BM = 256, BK = 64, HALF = 128, HTB = HALF * BK * 2, STAGE_BYTES = 8 * HTB, NXCD = 8, WGM = 8;
__host__ __device__ __forceinline__ int lds_byte(int r, int c) { const int st = (r >> 4) * 2 + (c >> 5), rr = r & 15, cc = c & 31, ob = rr * 64 + cc * 2; return st * 1024 + (ob ^ (((ob >> 9) & 1) << 5)); }
__host__ __device__ __forceinline__ void stage_rc(int b, int& R, int& C) { const int st = b / 1024, sb = b % 1024, swz = sb ^ (((sb >> 9) & 1) << 5); R = (st >> 1) * 16 + swz / 64; C = (st & 1) * 32 + (swz % 64) / 2; }
__host__ __device__ __forceinline__ int perm32(int rho) { const int n = rho >> 4, i = rho & 15; return 8 * (i >> 2) + 4 * n + (i & 3); }

struct Unit { int pm, pn, e, ti; };
struct StaticOrder {
    int nM, nN, nwg, G, c;
    __device__ __forceinline__ void init(int nM_, int nN_, int G_, int c_) { nM = nM_; nN = nN_; nwg = nM * nN; G = G_; c = c_; }
    __device__ __forceinline__ bool next(int i, Unit& u) const {
        const long L = (long)i * G + c; if (L >= nwg) return false;
        int wgid = (int)L; { const int q = nwg / NXCD, r = nwg % NXCD, xcd = wgid % NXCD, off = wgid / NXCD; wgid = (xcd < r ? xcd * (q + 1) : r * (q + 1) + (xcd - r) * q) + off; }
        const int nig = WGM * nN, gid = wgid / nig, fm = gid * WGM, gsz = (nM - fm) < WGM ? (nM - fm) : WGM;
        u.pm = fm + ((wgid % nig) % gsz); u.pn = (wgid % nig) / gsz; u.e = 0; u.ti = 0; return true;
    }
};

template <class Epi, class Sched, bool ALIGN_EPI>
__device__ __forceinline__ void gemm_phase(LAS unsigned char* lds, LAS unsigned char* misc, const Sched& S, const Epi& E) {
    constexpr bool GATHER = Sched::GATHER, FP8 = Sched::FP8;
    int tid_ = threadIdx.x; asm volatile("" : "+v"(tid_));
    const int tid = tid_, wid = __builtin_amdgcn_readfirstlane(tid >> 6), lane = tid & 63, wr = wid >> 2, wc = wid & 3, fr = lane & 15, fq = lane >> 4;
    const int K = S.K, nt = K / BK;
    unsigned voffA[2][2], voffB[2], colA2[2]; int rowA[2];
#pragma unroll
    for (int i = 0; i < 2; ++i) { int R, C; stage_rc(tid * 16 + i * 8192, R, C); const int Rb = (R & ~31) + perm32(R & 31);
        voffA[0][i] = voffA[1][i] = (unsigned)(R * K + C) * 2u; voffB[i] = (unsigned)(Rb * K + C) * 2u; rowA[i] = R; colA2[i] = (unsigned)C * 2u; }
    const size_t kstep = (size_t)(BK * 2);
    const size_t hstep = (size_t)HALF * K * 2;
    const size_t hstepA = GATHER ? (size_t)0 : hstep;
    const unsigned ldsw = (unsigned)wid * 1024u;
    const int aoff = FP8 ? lds_byte(wr * 64 + fr, (fq & 1) * 16) + (fq >> 1) * 1024 : lds_byte(wr * 64 + fr, fq * 8);
    const int boff = FP8 ? lds_byte(wc * 32 + fr, (fq & 1) * 16) + (fq >> 1) * 1024 : lds_byte(wc * 32 + fr, fq * 8);
    constexpr int KSTR = FP8 ? 16 : 1024;
#define PG8_SA(b, h) (((b) * 2 + (h)) * HTB)
#define PG8_SB(b, h) ((4 + (b) * 2 + (h)) * HTB)
#define PG8_STAGE(bufoff, gbase, voff) do { _Pragma("unroll") for (int _i = 0; _i < 2; ++_i) \
        __builtin_amdgcn_global_load_lds((const unsigned*)((const char*)(gbase) + (voff)[_i]), (LAS unsigned*)(lds + (bufoff) + ldsw + _i * 8192), 16, 0, 0); } while (0)
#define PG8_LDA(dst, b, h) do { _Pragma("unroll") for (int m = 0; m < 4; ++m) { const i32x4 f0_ = *(const LAS i32x4*)(lds + PG8_SA(b, h) + aoff + m * 2048), f1_ = *(const LAS i32x4*)(lds + PG8_SA(b, h) + aoff + m * 2048 + KSTR); dst[m] = __builtin_shufflevector(f0_, f1_, 0, 1, 2, 3, 4, 5, 6, 7); } } while (0)
#define PG8_LDB(dst, b, h) do { _Pragma("unroll") for (int n = 0; n < 2; ++n) { const i32x4 f0_ = *(const LAS i32x4*)(lds + PG8_SB(b, h) + boff + n * 2048), f1_ = *(const LAS i32x4*)(lds + PG8_SB(b, h) + boff + n * 2048 + KSTR); dst[n] = __builtin_shufflevector(f0_, f1_, 0, 1, 2, 3, 4, 5, 6, 7); } } while (0)
#define PG8_HALF(v, k) __builtin_bit_cast(bf16x8, __builtin_shufflevector(v, v, 4 * (k), 4 * (k) + 1, 4 * (k) + 2, 4 * (k) + 3))
#define PG8_MMA(ai, bj, At, Bt) do { __builtin_amdgcn_s_setprio(1); _Pragma("unroll") for (int m = 0; m < 4; ++m) _Pragma("unroll") for (int n = 0; n < 2; ++n) { \
        if constexpr (FP8) asm volatile("v_mfma_scale_f32_16x16x128_f8f6f4 %0, %1, %2, %0, %3, %3 op_sel_hi:[0,0,0]" : "+v"(acc[ai][bj][m][n]) : "v"(Bt[n]), "v"(At[m]), "v"(one_scale)); \
        else { acc[ai][bj][m][n] = __builtin_amdgcn_mfma_f32_16x16x32_bf16(PG8_HALF(Bt[n], 0), PG8_HALF(At[m], 0), acc[ai][bj][m][n], 0, 0, 0); \
               acc[ai][bj][m][n] = __builtin_amdgcn_mfma_f32_16x16x32_bf16(PG8_HALF(Bt[n], 1), PG8_HALF(At[m], 1), acc[ai][bj][m][n], 0, 0, 0); } } __builtin_amdgcn_s_setprio(0); } while (0)
#define PG8_WAIT_V(n) asm volatile("s_waitcnt vmcnt(" #n ")" ::: "memory")
#define PG8_WAIT_L(n) asm volatile("s_waitcnt lgkmcnt(" #n ")" ::: "memory")
#define PG8_BAR __builtin_amdgcn_s_barrier()
#define PG8_SCHED __builtin_amdgcn_sched_barrier(0)
    Unit cur, nxt; int ui = 0;
    if (!S.next(0, cur)) return;
    if constexpr (GATHER) {
#pragma unroll
        for (int h = 0; h < 2; ++h)
#pragma unroll
            for (int i = 0; i < 2; ++i) voffA[h][i] = (unsigned)S.tok(cur, h * HALF + rowA[i]) * (unsigned)(K * 2) + colA2[i];
    }
    f32x4 acc[2][2][4][2];
#pragma unroll
    for (int a = 0; a < 2; ++a)
#pragma unroll
        for (int b = 0; b < 2; ++b)
#pragma unroll
            for (int m = 0; m < 4; ++m)
#pragma unroll
                for (int n = 0; n < 2; ++n) acc[a][b][m][n] = (f32x4){0.f, 0.f, 0.f, 0.f};
    i32x8 At[4], B0[2], B1[2];
    const int one_scale = 0x7f7f7f7f;
    const char* cA = S.a_base(cur); const char* cB = S.b_base(cur);
    if (wid == 0) S.aux_dma(cur, 0, misc, lane);
    PG8_STAGE(PG8_SB(0, 0), cB, voffB); PG8_STAGE(PG8_SB(0, 1), cB + hstep, voffB); PG8_STAGE(PG8_SA(0, 0), cA, voffA[0]); PG8_STAGE(PG8_SA(0, 1), cA + hstepA, voffA[1]);
    if (wr == 1) PG8_BAR;
    PG8_WAIT_V(2); PG8_BAR;
    PG8_STAGE(PG8_SB(1, 0), cB + kstep, voffB); PG8_STAGE(PG8_SA(1, 0), cA + kstep, voffA[0]); PG8_STAGE(PG8_SB(1, 1), cB + hstep + kstep, voffB);
    PG8_WAIT_V(6); PG8_BAR;
    for (;;) {
        const bool has_next = S.next(ui + 1, nxt);
        const char* nA = has_next ? S.a_base(nxt) : cA; const char* nB = has_next ? S.b_base(nxt) : cB;
        unsigned nvoffA[2][2];
#pragma unroll
        for (int h = 0; h < 2; ++h)
#pragma unroll
            for (int i = 0; i < 2; ++i) nvoffA[h][i] = voffA[h][i];
        if constexpr (GATHER) {
            if (has_next && wid == 0) __builtin_amdgcn_global_load_lds((const unsigned*)(S.tok_ptr(nxt) + lane * 16), (LAS unsigned*)(misc + M_TOK), 16, 0, 0);
        }
        for (int t = 0; t < nt; t += 2) {
            const bool last = (t == nt - 2);
            if (t == 2 && has_next && wid == 0) S.aux_dma(nxt, ui + 1, misc, lane);
            const char* a1 = cA + (size_t)(t + 1) * kstep;
            const char* a2 = last ? nA : cA + (size_t)(t + 2) * kstep; const char* b2 = last ? nB : cB + (size_t)(t + 2) * kstep;
            const char* a3 = a2 + kstep; const char* b3 = b2 + kstep;
            unsigned va2[2][2];
            if constexpr (GATHER) {
                if (last && has_next) {
#pragma unroll
                    for (int h = 0; h < 2; ++h)
#pragma unroll
                        for (int i = 0; i < 2; ++i) { const unsigned tk = *(const LAS unsigned*)(misc + M_TOK + (h * HALF + rowA[i]) * 4); nvoffA[h][i] = ((tk >> 1) & (unsigned)(T - 1)) * (unsigned)(K * 2) + colA2[i]; }
                }
#pragma unroll
                for (int h = 0; h < 2; ++h)
#pragma unroll
                    for (int i = 0; i < 2; ++i) va2[h][i] = last ? nvoffA[h][i] : voffA[h][i];
            } else {
#pragma unroll
                for (int h = 0; h < 2; ++h)
#pragma unroll
                    for (int i = 0; i < 2; ++i) va2[h][i] = voffA[h][i];
            }
            PG8_LDB(B0, 0, 0); PG8_LDB(B1, 0, 1); PG8_SCHED; PG8_LDA(At, 0, 0); PG8_STAGE(PG8_SA(1, 1), a1 + hstepA, voffA[1]);
            PG8_WAIT_V(8); PG8_WAIT_L(0); PG8_BAR; PG8_MMA(0, 0, At, B0); PG8_MMA(0, 1, At, B1); PG8_BAR; PG8_SCHED;
            PG8_LDA(At, 0, 1); PG8_STAGE(PG8_SB(0, 0), b2, voffB); PG8_STAGE(PG8_SB(0, 1), b2 + hstep, voffB); PG8_STAGE(PG8_SA(0, 0), a2, va2[0]);
            PG8_WAIT_V(8); PG8_WAIT_L(0); PG8_BAR; PG8_MMA(1, 0, At, B0); PG8_MMA(1, 1, At, B1); PG8_BAR; PG8_SCHED;
            PG8_LDB(B0, 1, 0); PG8_LDB(B1, 1, 1); PG8_SCHED; PG8_LDA(At, 1, 0); PG8_STAGE(PG8_SA(0, 1), a2 + hstepA, va2[1]);
            PG8_WAIT_V(8); PG8_WAIT_L(0); PG8_BAR; PG8_MMA(0, 0, At, B0); PG8_MMA(0, 1, At, B1); PG8_BAR; PG8_SCHED;
            PG8_LDA(At, 1, 1); PG8_STAGE(PG8_SB(1, 0), b3, voffB); PG8_STAGE(PG8_SB(1, 1), b3 + hstep, voffB); PG8_STAGE(PG8_SA(1, 0), a3, va2[0]);
            PG8_WAIT_V(8); PG8_WAIT_L(0); PG8_BAR; PG8_MMA(1, 0, At, B0); PG8_MMA(1, 1, At, B1); PG8_BAR; PG8_SCHED;
        }
        if constexpr (FP8) asm volatile("s_nop 15\n\ts_nop 15" ::: "memory");
        if constexpr (ALIGN_EPI) { if (wr == 0) PG8_BAR; }
        E(acc, cur, wr, wc, fr, fq, misc, ui);
        if (!has_next) break;
        bool zero = true;
        if constexpr (Epi::KEEP_ACC) zero = !E.keep(cur);
        if (zero) {
#pragma unroll
        for (int a = 0; a < 2; ++a)
#pragma unroll
            for (int b = 0; b < 2; ++b)
#pragma unroll
                for (int m = 0; m < 4; ++m)
#pragma unroll
                    for (int n = 0; n < 2; ++n) acc[a][b][m][n] = (f32x4){0.f, 0.f, 0.f, 0.f};
        }
        cur = nxt; cA = nA; cB = nB; ++ui;
#pragma unroll
        for (int h = 0; h < 2; ++h)
#pragma unroll
            for (int i = 0; i < 2; ++i) voffA[h][i] = nvoffA[h][i];
        if constexpr (ALIGN_EPI) { if (wr == 1) PG8_BAR; }
    }
    PG8_WAIT_V(0);
    if constexpr (!ALIGN_EPI) { if (wr == 0) PG8_BAR; }
    PG8_BAR;
#undef PG8_SA
#undef PG8_SB
#undef PG8_STAGE
#undef PG8_LDA
#undef PG8_LDB
#undef PG8_HALF
#undef PG8_MMA
#undef PG8_WAIT_V
#undef PG8_WAIT_L
#undef PG8_BAR
#undef PG8_SCHED
}
}

template <bool F8_> struct PlainSchedT {
    static constexpr bool GATHER = false, FP8 = F8_;
    pg8::StaticOrder so; const char* A; const char* Bt; int K;
    __device__ __forceinline__ bool next(int i, pg8::Unit& u) const { return so.next(i, u); }
    __device__ __forceinline__ const char* a_base(const pg8::Unit& u) const { return A + (size_t)u.pm * 256 * K * 2; }
    __device__ __forceinline__ const char* b_base(const pg8::Unit& u) const { return Bt + (size_t)u.pn * 256 * K * 2; }
    __device__ __forceinline__ int tok(const pg8::Unit&, int) const { return 0; }
    __device__ __forceinline__ const char* tok_ptr(const pg8::Unit&) const { return nullptr; }
    __device__ __forceinline__ void aux_dma(const pg8::Unit&, int, LAS unsigned char*, int) const {}
};
typedef PlainSchedT<false> PlainSched;
struct PairSched {
    static constexpr bool GATHER = false, FP8 = false;
    pg8::StaticOrder so; const char* A; const char* Bt; int K;
    __device__ __forceinline__ bool next(int i, pg8::Unit& u) const { pg8::Unit b; if (!so.next(i >> 1, b)) return false; const int br = i & 1; u.pm = b.pm + 64 * br; u.pn = b.pn + 4 * br; u.e = 0; u.ti = 0; return true; }
    __device__ __forceinline__ const char* a_base(const pg8::Unit& u) const { return A + (size_t)u.pm * 256 * K * 2; }
    __device__ __forceinline__ const char* b_base(const pg8::Unit& u) const { return Bt + (size_t)u.pn * 256 * K * 2; }
    __device__ __forceinline__ int tok(const pg8::Unit&, int) const { return 0; }
    __device__ __forceinline__ const char* tok_ptr(const pg8::Unit&) const { return nullptr; }
    __device__ __forceinline__ void aux_dma(const pg8::Unit&, int, LAS unsigned char*, int) const {}
};
struct MoeTiles { int tstart[NE + 1]; int cnt[NE]; };
template <bool G_> struct MoeSched {
    static constexpr bool GATHER = G_, FP8 = true;
    pg8::StaticOrder so; const char* A; const char* Bt; int K; size_t bexp; MoeTiles mt; const int* rowtok;
    __device__ __forceinline__ bool next(int i, pg8::Unit& u) const { if (!so.next(i, u)) return false; int e = 0;
#pragma unroll
        for (int j = 1; j < NE; ++j) e += (u.pm >= mt.tstart[j]) ? 1 : 0;
        int ts = 0;
#pragma unroll
        for (int j = 1; j < NE; ++j) ts = (e == j) ? mt.tstart[j] : ts;
        u.e = e; u.ti = u.pm - ts; return true; }
    __device__ __forceinline__ const char* a_base(const pg8::Unit& u) const { return GATHER ? A : A + (size_t)u.pm * 256 * K * 2; }
    __device__ __forceinline__ const char* b_base(const pg8::Unit& u) const { return Bt + (size_t)u.e * bexp + (size_t)u.pn * 256 * K * 2; }
    __device__ __forceinline__ int tok(const pg8::Unit& u, int r) const { return (rowtok[u.e * 16384 + u.ti * 256 + r] >> 1) & (T - 1); }
    __device__ __forceinline__ const char* tok_ptr(const pg8::Unit& u) const { return (const char*)(rowtok + u.e * 16384 + u.ti * 256); }
    const float* aux0; const float* aux1;
    __device__ __forceinline__ void aux_dma(const pg8::Unit& u, int ui, LAS unsigned char* misc, int lane) const { const int lb = u.e * 16384 + u.ti * 256 + lane * 4; LAS unsigned char* t = misc + M_AUX + (ui & 1) * 2048;
        __builtin_amdgcn_global_load_lds((const unsigned*)(aux0 + lb), (LAS unsigned*)t, 16, 0, 0);
        if constexpr (!GATHER) __builtin_amdgcn_global_load_lds((const unsigned*)(aux1 + lb), (LAS unsigned*)(t + 1024), 16, 0, 0); }
};

__device__ __forceinline__ float row_rs(const float* ssq, int row) { return __builtin_amdgcn_rsqf((ssq[row] + ssq[T + row] + ssq[2 * T + row] + ssq[3 * T + row]) * (1.0f / D) + EPS); }

struct EpiA {   static constexpr bool KEEP_ACC = false;
    bf16_t* planes; const float* ssq;
    __device__ __forceinline__ void operator()(const f32x4 (&acc)[2][2][4][2], const pg8::Unit& u, int wr, int wc, int fr, int fq, LAS unsigned char* misc, int ui) const {
        const int row0 = u.pm * 256 + wr * 64 + fr; const LAS float* rst = (const LAS float*)(misc + M_AUX) + ui * 256 + wr * 64 + fr;
        if (u.pn < 8) {
            bf16_t* base = planes + (size_t)row0 * D + u.pn * 128 + wc * 32 + 8 * fq;
#pragma unroll
            for (int ai = 0; ai < 2; ++ai)
#pragma unroll
                for (int m = 0; m < 4; ++m) { const int r = ai * 128 + m * 16; const float rs = rst[r];
                    const float cc = rs * -1.44269504089f; const f32x4 o0 = glu4(acc[ai][0][m][0], acc[ai][1][m][0], cc, rs), o1 = glu4(acc[ai][0][m][1], acc[ai][1][m][1], cc, rs);
                    *(u32x4*)(base + (size_t)r * D) = pack8(o0, o1); }
        } else if (u.pn < 16) {
            const int p = (u.pn - 8) >> 2, colt = ((u.pn - 8) & 3) * 256;
            bf16_t* base = planes + (size_t)(1 + p) * PLANE + (size_t)row0 * D + colt + wc * 32 + 8 * fq;
#pragma unroll
            for (int ai = 0; ai < 2; ++ai)
#pragma unroll
                for (int m = 0; m < 4; ++m) { const int r = ai * 128 + m * 16; const float rs = rst[r];
#pragma unroll
                    for (int bj = 0; bj < 2; ++bj) *(u32x4*)(base + (size_t)r * D + bj * 128) = pack8(gelu4(acc[ai][bj][m][0] * rs), gelu4(acc[ai][bj][m][1] * rs)); }
        } else {
            bf16_t* base = planes + (size_t)3 * PLANE + (size_t)row0 * D + (u.pn - 16) * 128 + wc * 32 + 8 * fq;
#pragma unroll
            for (int ai = 0; ai < 2; ++ai)
#pragma unroll
                for (int m = 0; m < 4; ++m) { const int r = ai * 128 + m * 16; const float rs = rst[r] * -1.44269504089f; f32x4 rt[2], sb[2];
#pragma unroll
                    for (int n = 0; n < 2; ++n) { const f32x4 ga = acc[ai][0][m][n] * rs, gb = acc[ai][1][m][n] * rs;
                        f32x4 da, db, ra;
#pragma unroll
                        for (int i = 0; i < 4; ++i) { da[i] = __builtin_amdgcn_exp2f(ga[i]); db[i] = __builtin_amdgcn_exp2f(gb[i]); }
                        da = da + 1.0f; db = db + 1.0f;
#pragma unroll
                        for (int i = 0; i < 4; ++i) { ra[i] = __builtin_amdgcn_rcpf(da[i]); sb[n][i] = __builtin_amdgcn_rcpf(db[i]); }
                        rt[n] = db * ra; }
                    *(u32x4*)(base + (size_t)r * D) = pack8(rt[0], rt[1]); *(u32x4*)(base + PLANE + (size_t)r * D) = pack8(sb[0], sb[1]); }
        }
    }
};
struct EpiC {   static constexpr bool KEEP_ACC = true;
    bf16_t* mplane; const bf16_t* gates;
    __device__ __forceinline__ bool keep(const pg8::Unit& u) const { return (u.pn >> 2) == 0; }
    __device__ __forceinline__ void operator()(f32x4 (&acc)[2][2][4][2], const pg8::Unit& u, int wr, int wc, int fr, int fq, LAS unsigned char* misc, int ui) const {
        const int br = u.pn >> 2, pn = u.pn & 3, pm = u.pm - 64 * br;
        const size_t off0 = (size_t)(pm * 256 + wr * 64 + fr) * D + pn * 256 + wc * 32 + 8 * fq;
        const bf16_t* gp = gates + (size_t)br * PLANE + off0; bf16_t* mp = mplane + off0;
        u32x4 g[2][4][2];
#pragma unroll
        for (int ai = 0; ai < 2; ++ai)
#pragma unroll
            for (int m = 0; m < 4; ++m)
#pragma unroll
                for (int bj = 0; bj < 2; ++bj) g[ai][m][bj] = *(const u32x4*)(gp + (size_t)(ai * 128 + m * 16) * D + bj * 128);
#pragma unroll
        for (int ai = 0; ai < 2; ++ai)
#pragma unroll
            for (int m = 0; m < 4; ++m)
#pragma unroll
                for (int bj = 0; bj < 2; ++bj) { acc[ai][bj][m][0] *= unpk_lo(g[ai][m][bj]); acc[ai][bj][m][1] *= unpk_hi(g[ai][m][bj]); }
        if (br) {
#pragma unroll
            for (int ai = 0; ai < 2; ++ai)
#pragma unroll
                for (int m = 0; m < 4; ++m)
#pragma unroll
                    for (int bj = 0; bj < 2; ++bj) *(u32x4*)(mp + (size_t)(ai * 128 + m * 16) * D + bj * 128) = pack8(acc[ai][bj][m][0], acc[ai][bj][m][1]);
        }
    }
};
template <bool XF, bool ROUTE> struct EpiD {   static constexpr bool KEEP_ACC = false;
    const float* xf; bf16_t* xb; float* ssq; unsigned char* xq; float* plg; float scale;
    __device__ __forceinline__ void operator()(f32x4 (&acc)[2][2][4][2], const pg8::Unit& u, int wr, int wc, int fr, int fq, LAS unsigned char* misc, int ui) const {
        const size_t off0 = (size_t)(u.pm * 256 + wr * 64 + fr) * D + u.pn * 256 + wc * 32 + 8 * fq;
        LAS float* P = (LAS float*)(misc + M_P);
        if constexpr (XF) {
#pragma unroll
            for (int am = 0; am < 4; ++am) { const int ai = am >> 1, m0 = (am & 1) * 2; f32x4 xo[2][2][2];
#pragma unroll
                for (int m = 0; m < 2; ++m)
#pragma unroll
                    for (int bj = 0; bj < 2; ++bj) { const float* p = xf + off0 + (size_t)(ai * 128 + (m0 + m) * 16) * D + bj * 128; xo[m][bj][0] = *(const f32x4*)p; xo[m][bj][1] = *(const f32x4*)(p + 4); }
#pragma unroll
                for (int m = 0; m < 2; ++m)
#pragma unroll
                    for (int bj = 0; bj < 2; ++bj) { acc[ai][bj][m0 + m][0] = xo[m][bj][0] + acc[ai][bj][m0 + m][0] * scale; acc[ai][bj][m0 + m][1] = xo[m][bj][1] + acc[ai][bj][m0 + m][1] * scale;
                        asm volatile("" : "+v"(acc[ai][bj][m0 + m][0]), "+v"(acc[ai][bj][m0 + m][1]) :: "memory"); } }
        } else {
#pragma unroll
            for (int ai = 0; ai < 2; ++ai) { u32x4 xo[4][2];
#pragma unroll
                for (int m = 0; m < 4; ++m)
#pragma unroll
                    for (int bj = 0; bj < 2; ++bj) xo[m][bj] = *(const u32x4*)(xb + off0 + (size_t)(ai * 128 + m * 16) * D + bj * 128);
#pragma unroll
                for (int m = 0; m < 4; ++m)
#pragma unroll
                    for (int bj = 0; bj < 2; ++bj) { acc[ai][bj][m][0] = unpk_lo(xo[m][bj]) + acc[ai][bj][m][0] * scale; acc[ai][bj][m][1] = unpk_hi(xo[m][bj]) + acc[ai][bj][m][1] * scale;
                        asm volatile("" : "+v"(acc[ai][bj][m][0]), "+v"(acc[ai][bj][m][1]) :: "memory"); } }
        }
#pragma unroll
        for (int ai = 0; ai < 2; ++ai)
#pragma unroll
            for (int m = 0; m < 4; ++m) { float sq = 0.f;
#pragma unroll
                for (int bj = 0; bj < 2; ++bj) { const size_t o = off0 + (size_t)(ai * 128 + m * 16) * D + bj * 128;
                    const f32x4 v0 = acc[ai][bj][m][0], v1 = acc[ai][bj][m][1];
                    *(u32x4*)(xb + o) = pack8(v0, v1); if constexpr (ROUTE) *(u32x2*)(xq + o) = pack8_fp8(v0, v1);
                    sq += (v0[0] * v0[0] + v0[1] * v0[1]) + (v0[2] * v0[2] + v0[3] * v0[3]) + (v1[0] * v1[0] + v1[1] * v1[1]) + (v1[2] * v1[2] + v1[3] * v1[3]); }
                sq += __shfl_xor(sq, 16); sq += __shfl_xor(sq, 32);
                if (fq == 0) P[(ai * 128 + wr * 64 + m * 16 + fr) * 4 + wc] = sq; }
        asm volatile("s_waitcnt lgkmcnt(0)" ::: "memory"); __builtin_amdgcn_s_barrier(); asm volatile("" ::: "memory");
        const int tid = threadIdx.x;
        if (tid < 256) { const f32x4 p = *(const LAS f32x4*)(P + tid * 4); ssq[(size_t)u.pn * T + u.pm * 256 + tid] = (p[0] + p[1]) + (p[2] + p[3]); }
        asm volatile("s_waitcnt lgkmcnt(0)" ::: "memory"); __builtin_amdgcn_s_barrier(); asm volatile("" ::: "memory");
        if constexpr (ROUTE) {
            const LAS float* RW = (const LAS float*)(misc + M_AUX); LAS float* PL = (LAS float*)(misc + M_PL);
            const int cl = wc * 32 + 8 * fq;
#pragma unroll
            for (int hf = 0; hf < 2; ++hf) {
#pragma unroll
                for (int e4 = 0; e4 < 4; ++e4) { const int e = hf * 4 + e4; f32x4 w[2][2];
#pragma unroll
                    for (int bj = 0; bj < 2; ++bj) { w[bj][0] = *(const LAS f32x4*)(RW + e * 256 + bj * 128 + cl); w[bj][1] = *(const LAS f32x4*)(RW + e * 256 + bj * 128 + cl + 4); }
#pragma unroll
                    for (int ai = 0; ai < 2; ++ai)
#pragma unroll
                        for (int m = 0; m < 4; ++m) { f32x4 t = acc[ai][0][m][0] * w[0][0] + acc[ai][0][m][1] * w[0][1] + acc[ai][1][m][0] * w[1][0] + acc[ai][1][m][1] * w[1][1];
                            float d = (t[0] + t[1]) + (t[2] + t[3]); d += __shfl_xor(d, 16); d += __shfl_xor(d, 32);
                            if (fq == 0) PL[((ai * 128 + wr * 64 + m * 16 + fr) * 4 + wc) * 4 + e4] = d; } }
                asm volatile("s_waitcnt lgkmcnt(0)" ::: "memory"); __builtin_amdgcn_s_barrier(); asm volatile("" ::: "memory");
                if (tid < 256) { const LAS f32x4* q = (const LAS f32x4*)(PL + tid * 16); const f32x4 sum = (q[0] + q[1]) + (q[2] + q[3]);
                    *(f32x4*)(plg + ((size_t)u.pn * T + u.pm * 256 + tid) * 8 + hf * 4) = sum; }
                asm volatile("s_waitcnt lgkmcnt(0)" ::: "memory"); __builtin_amdgcn_s_barrier(); asm volatile("" ::: "memory");
            }
        }
    }
};
struct EpiE {   static constexpr bool KEEP_ACC = false;
    bf16_t* hid; const float* ssq; int ldh; int f8;
    __device__ __forceinline__ void operator()(const f32x4 (&acc)[2][2][4][2], const pg8::Unit& u, int wr, int wc, int fr, int fq, LAS unsigned char* misc, int ui) const {
        const int row0 = u.pm * 256 + wr * 64 + fr; const LAS float* rst = (const LAS float*)(misc + M_AUX) + ui * 256 + wr * 64 + fr;
        bf16_t* base = hid + (size_t)row0 * ldh + u.pn * 128 + wc * 32 + 8 * fq;
#pragma unroll
        for (int ai = 0; ai < 2; ++ai)
#pragma unroll
            for (int m = 0; m < 4; ++m) { const int r = ai * 128 + m * 16; const float rs = rst[r];
                f32x4 o[2];
#pragma unroll
                for (int n = 0; n < 2; ++n) o[n] = swiglu4(acc[ai][0][m][n], acc[ai][1][m][n], rs * -1.44269504089f, rs * rs);
                if (f8) *(u32x2*)((unsigned char*)hid + (size_t)(row0 + r) * ldh + u.pn * 128 + wc * 32 + 8 * fq) = pack8_fp8(o[0], o[1]); else *(u32x4*)(base + (size_t)r * ldh) = pack8(o[0], o[1]); }
    }
};
struct EpiG {   static constexpr bool KEEP_ACC = false;
    bf16_t* hid; const float* rowrs;
    __device__ __forceinline__ void operator()(const f32x4 (&acc)[2][2][4][2], const pg8::Unit& u, int wr, int wc, int fr, int fq, LAS unsigned char* misc, int ui) const {
        const int rl0 = wr * 64 + fr;
        unsigned char* base = (unsigned char*)hid + (size_t)(u.pm * 256 + rl0) * FFE + u.pn * 128 + wc * 32 + 8 * fq;
        const LAS float* rsp = (const LAS float*)(misc + M_AUX + (ui & 1) * 2048) + rl0;
#pragma unroll
        for (int ai = 0; ai < 2; ++ai)
#pragma unroll
            for (int m = 0; m < 4; ++m) { const int r = ai * 128 + m * 16; const float rs = rsp[r] * (1.0f / W13_SCALE);
                f32x4 o[2];
#pragma unroll
                for (int n = 0; n < 2; ++n) o[n] = swiglu4(acc[ai][0][m][n], acc[ai][1][m][n], rs * -1.44269504089f, rs * rs);
                *(u32x2*)(base + (size_t)r * FFE) = pack8_fp8(o[0], o[1]); }
    }
};
struct EpiH {   static constexpr bool KEEP_ACC = false;
    bf16_t* slots; const int* rowtok; const float* rowgate; MoeTiles mt;
    __device__ __forceinline__ void operator()(const f32x4 (&acc)[2][2][4][2], const pg8::Unit& u, int wr, int wc, int fr, int fq, LAS unsigned char* misc, int ui) const {
        int cnt = 0;
#pragma unroll
        for (int j = 0; j < NE; ++j) cnt = (u.e == j) ? mt.cnt[j] : cnt;
        const int nvalid = cnt - u.ti * 256, rl0 = wr * 64 + fr, col = u.pn * 256 + wc * 32 + 8 * fq;
        const LAS int* tst = (const LAS int*)(misc + M_AUX + (ui & 1) * 2048) + rl0; const LAS float* tgt = (const LAS float*)(misc + M_AUX + (ui & 1) * 2048 + 1024) + rl0;
#pragma unroll
        for (int ai = 0; ai < 2; ++ai)
#pragma unroll
            for (int m = 0; m < 4; ++m) { const int r = ai * 128 + m * 16;
                if (rl0 + r < nvalid) { const int ts = tst[r] & (2 * T - 1); const float g = tgt[r] * (1.0f / W2_SCALE);
                    bf16_t* o = slots + (size_t)ts * D + col;
#pragma unroll
                    for (int bj = 0; bj < 2; ++bj) *(u32x4*)(o + bj * 128) = pack8(acc[ai][bj][m][0] * g, acc[ai][bj][m][1] * g); } }
    }
};

template <class Sched> __device__ __forceinline__ void build_rs_table(const Sched& S, LAS unsigned char* misc, const float* ssq, int tid) {
    const int nu = (S.so.nwg - S.so.c + S.so.G - 1) / S.so.G;
    if (tid < 256 && nu > 0) { float q[6][4];
#pragma unroll
        for (int i = 0; i < 6; ++i) { pg8::Unit u; S.next(i < nu ? i : nu - 1, u); const float* p = ssq + u.pm * 256 + tid;
#pragma unroll
            for (int j = 0; j < 4; ++j) q[i][j] = p[j * T]; }
#pragma unroll
        for (int i = 0; i < 6; ++i) if (i < nu) ((LAS float*)(misc + M_AUX))[i * 256 + tid] = __builtin_amdgcn_rsqf(((q[i][0] + q[i][1]) + (q[i][2] + q[i][3])) * (1.0f / D) + EPS); }
    __syncthreads();
}

#define XB_TMO      128
#define XB_XCNT(j)  (256  + 64 * (j))
#define XB_XSUB(j)  (1280 + 64 * (j))
#define XB_XGEN(j)  (2304 + 64 * (j))
#define XB_TOP      3328
#define XB_TOPGEN   3392
#define XCD_BAR_WORDS 3456
#define XB_SPIN_CAP (1u << 18)
__device__ __forceinline__ unsigned xb_ld(unsigned* p)              { return __hip_atomic_load(p, __ATOMIC_RELAXED, __HIP_MEMORY_SCOPE_AGENT); }
__device__ __forceinline__ unsigned xb_add(unsigned* p, unsigned v) { return __hip_atomic_fetch_add(p, v, __ATOMIC_RELAXED, __HIP_MEMORY_SCOPE_AGENT); }
__device__ __forceinline__ unsigned xb_xcc_id() { return (unsigned)__builtin_amdgcn_s_getreg((3 << 11) | 20) & 0xFu; }
#define XB_SPIN(cond, bar) do { unsigned _sp = 0; while (cond) { __builtin_amdgcn_s_sleep(1); \
    if ((++_sp & 255u) == 0u) { if (xb_ld(&(bar)[XB_TMO])) break; if (_sp > XB_SPIN_CAP) { atomicAdd(&(bar)[XB_TMO], 1u); break; } } } } while (0)
struct XcdBarrier { unsigned* bar; unsigned x; volatile LAS unsigned* st; };
__device__ __forceinline__ XcdBarrier xcd_barrier_post(unsigned* bar, volatile LAS unsigned* st) {
    XcdBarrier b; b.bar = bar; b.x = xb_xcc_id(); b.st = st;
    if (threadIdx.x == 0) (void)xb_add(&bar[XB_XCNT(b.x)], 1u);
    return b;
}
__device__ __forceinline__ void xcd_barrier_complete(unsigned* bar, unsigned x, unsigned& nloc, unsigned& nx) {
    const unsigned G = gridDim.x * gridDim.y * gridDim.z;
    unsigned sum, cnt, mine, sp = 0u;
    for (;;) {
        sum = 0u; cnt = 0u; mine = 0u;
#pragma unroll
        for (unsigned j = 0; j < 16; ++j) { const unsigned c = xb_ld(&bar[XB_XCNT(j)]); sum += c; cnt += (c > 0u) ? 1u : 0u; mine = (j == x) ? c : mine; }
        if (sum == G) break;
        __builtin_amdgcn_s_sleep(1);
        if ((++sp & 255u) == 0u) { if (xb_ld(&bar[XB_TMO])) break; if (sp > XB_SPIN_CAP) { atomicAdd(&bar[XB_TMO], 1u); break; } }
    }
    nloc = mine > 0u ? mine : 1u; nx = cnt > 0u ? cnt : 1u;
}
__device__ __forceinline__ void xcd_barrier(const XcdBarrier& b) {
    asm volatile("s_waitcnt vmcnt(0)" ::: "memory");
    __syncthreads();
    if (threadIdx.x == 0) {
        unsigned* bar = b.bar;
        __builtin_amdgcn_s_waitcnt(0);
        unsigned nloc = b.st[0], nx = b.st[1];
        if (nloc == 0u) { xcd_barrier_complete(bar, b.x, nloc, nx); b.st[0] = nloc; b.st[1] = nx; }
        const unsigned old = xb_add(&bar[XB_XSUB(b.x)], 1u);
        const unsigned gen = old / nloc;
        if (old + 1u == (gen + 1u) * nloc) {
            __builtin_amdgcn_fence(__ATOMIC_RELEASE, "agent");
            asm volatile("s_waitcnt vmcnt(0)" ::: "memory");
            const unsigned og = xb_add(&bar[XB_TOP], 1u);
            const unsigned tg = og / nx;
            if (og + 1u == (tg + 1u) * nx) xb_add(&bar[XB_TOPGEN], 1u);
            else XB_SPIN(xb_ld(&bar[XB_TOPGEN]) == tg, bar);
            __builtin_amdgcn_fence(__ATOMIC_ACQUIRE, "agent");
            xb_add(&bar[XB_XGEN(b.x)], 1u);
            asm volatile("s_waitcnt vmcnt(0)" ::: "memory");
        } else {
            XB_SPIN(xb_ld(&bar[XB_XGEN(b.x)]) == gen, bar);
            __builtin_amdgcn_fence(__ATOMIC_ACQUIRE, "agent");
            asm volatile("s_waitcnt vmcnt(0)" ::: "memory");
        }
    }
    __syncthreads();
}

__device__ __forceinline__ void xpose_item(const float* W, int ldw, const float* g, bf16_t* WT, int Kd, int kb, int nb, int blk, int off, LAS float* scr, int lane) {
    const int k0 = 64 * kb, n0 = 64 * nb;
    const float* src = W + (size_t)k0 * ldw + n0 + lane;
    float v[64];
#pragma unroll
    for (int i = 0; i < 64; ++i) v[i] = __builtin_nontemporal_load(src + (size_t)i * ldw);
    if (g) {
#pragma unroll
        for (int i = 0; i < 64; ++i) scr[i * 65 + lane] = v[i] * g[k0 + i];
    } else {
#pragma unroll
        for (int i = 0; i < 64; ++i) scr[i * 65 + lane] = v[i];
    }
    asm volatile("s_waitcnt lgkmcnt(0)" ::: "memory");
    const int c = lane & 7;
#pragma unroll
    for (int j = 0; j < 8; ++j) { const int n = (lane >> 3) + 8 * j, nn = n0 + n; const LAS float* s = scr + (8 * c) * 65 + n;
        u32x4 o; o.x = cvt_pk_bf16(s[0 * 65], s[1 * 65]); o.y = cvt_pk_bf16(s[2 * 65], s[3 * 65]); o.z = cvt_pk_bf16(s[4 * 65], s[5 * 65]); o.w = cvt_pk_bf16(s[6 * 65], s[7 * 65]);
        *(u32x4*)(WT + (size_t)((nn >> 7) * blk + (nn & 127) + off) * Kd + k0 + 8 * c) = o; }
    asm volatile("s_waitcnt lgkmcnt(0)" ::: "memory");
}

__device__ __forceinline__ void xpose_item_fp8(const float* W, int ldw, const float* g, float sc, unsigned char* WT, int Kd, int kb, int nb, int blk, int off, LAS float* scr, int lane) {
    const int k0 = 64 * kb, n0 = 64 * nb;
    const float* src = W + (size_t)k0 * ldw + n0 + lane;
    float v[64];
#pragma unroll
    for (int i = 0; i < 64; ++i) v[i] = __builtin_nontemporal_load(src + (size_t)i * ldw);
    if (g) {
#pragma unroll
        for (int i = 0; i < 64; ++i) scr[i * 65 + lane] = v[i] * (g[k0 + i] * sc);
    } else {
#pragma unroll
        for (int i = 0; i < 64; ++i) scr[i * 65 + lane] = v[i] * sc;
    }
    asm volatile("s_waitcnt lgkmcnt(0)" ::: "memory");
    const int c = lane & 7;
#pragma unroll
    for (int j = 0; j < 8; ++j) { const int n = (lane >> 3) + 8 * j, nn = n0 + n; const LAS float* s = scr + (8 * c) * 65 + n;
        *(u32x2*)(WT + (size_t)((nn >> 7) * blk + (nn & 127) + off) * Kd + k0 + 8 * c) = pack8_fp8((f32x4){s[0 * 65], s[1 * 65], s[2 * 65], s[3 * 65]}, (f32x4){s[4 * 65], s[5 * 65], s[6 * 65], s[7 * 65]}); }
    asm volatile("s_waitcnt lgkmcnt(0)" ::: "memory");
}

struct Args { const float* in[23]; float* out; unsigned char* ws; int ph_lo, ph_hi; };
#define CAS __attribute__((address_space(4)))
typedef const CAS Args* ArgP;
__device__ __forceinline__ ArgP fresh_args() { unsigned long long p = (unsigned long long)__builtin_amdgcn_kernarg_segment_ptr(); asm volatile("" : "+s"(p)); return (ArgP)p; }
enum { I_X = 0, I_GMIX, I_WIN, I_CONVW, I_CONVB, I_CLNG, I_CLNB, I_WCO, I_SLNG, I_SLNB, I_SGW, I_SGB, I_WSO, I_WO, I_GFFN, I_F1, I_F3, I_F2, I_ROUTER, I_M1, I_M3, I_M2, I_GFINAL };


constexpr int IT_LAYER = 2304, IT_FFN = 2112, IT_EXP = 2688, IT_TOTAL = 2 * IT_LAYER + IT_FFN + NE * IT_EXP;
__device__ __forceinline__ void convert_item(ArgP ap, unsigned char* ws, int it, LAS float* scr, int lane) {
    int r = it;
    if (r < 2 * IT_LAYER) { const int l = r / IT_LAYER; r -= l * IT_LAYER;
        const float* win = ap->in[I_WIN] + (size_t)l * D * NIN; const float* gm = ap->in[I_GMIX] + l * D;
        bf16_t* wint = (bf16_t*)(ws + WS_WIN) + (size_t)l * NIN * D; bf16_t* wcs = (bf16_t*)(ws + WS_WCS) + (size_t)l * 2048 * D; bf16_t* wot = (bf16_t*)(ws + WS_WO) + (size_t)l * D * D;
        if (r < 256) { xpose_item(win, NIN, gm, wint, D, r >> 4, r & 15, 256, 0, scr, lane); return; } r -= 256;
        if (r < 256) { xpose_item(win + 1024, NIN, gm, wint, D, r >> 4, r & 15, 256, 128, scr, lane); return; } r -= 256;
        if (r < 512) { xpose_item(win + 2048, NIN, gm, wint, D, r >> 5, r & 31, 128, 2048, scr, lane); return; } r -= 512;
        if (r < 256) { xpose_item(win + 4096, NIN, gm, wint, D, r >> 4, r & 15, 256, 4096, scr, lane); return; } r -= 256;
        if (r < 256) { xpose_item(win + 5120, NIN, gm, wint, D, r >> 4, r & 15, 256, 4096 + 128, scr, lane); return; } r -= 256;
        if (r < 256) { xpose_item(ap->in[I_WCO] + (size_t)l * D * D, D, nullptr, wcs, D, r >> 4, r & 15, 128, 0, scr, lane); return; } r -= 256;
        if (r < 256) { xpose_item(ap->in[I_WSO] + (size_t)l * D * D, D, nullptr, wcs, D, r >> 4, r & 15, 128, 1024, scr, lane); return; } r -= 256;
        xpose_item(ap->in[I_WO] + (size_t)l * D * D, D, nullptr, wot, D, r >> 4, r & 15, 128, 0, scr, lane); return; }
    r -= 2 * IT_LAYER;
    if (r < IT_FFN) { const float* gf = ap->in[I_GFFN];
        if (r < 704) { xpose_item(ap->in[I_F1], FFD, gf, (bf16_t*)(ws + WS_WF13), D, r / 44, r % 44, 256, 0, scr, lane); return; } r -= 704;
        if (r < 704) { xpose_item(ap->in[I_F3], FFD, gf, (bf16_t*)(ws + WS_WF13), D, r / 44, r % 44, 256, 128, scr, lane); return; } r -= 704;
        if (FFN_DOWN_FP8) xpose_item_fp8(ap->in[I_F2], D, nullptr, W2_SCALE, ws + WS_WF2, FFD, r >> 4, r & 15, 128, 0, scr, lane);
        else xpose_item(ap->in[I_F2], D, nullptr, (bf16_t*)(ws + WS_WF2), FFD, r >> 4, r & 15, 128, 0, scr, lane);
        return; }
    r -= IT_FFN;
    { const int e = r / IT_EXP; r -= e * IT_EXP; const float* gf = ap->in[I_GFFN] + D;
        unsigned char* w13 = ws + WS_WM13 + (size_t)e * 2 * FFE * D; unsigned char* w2 = ws + WS_WM2 + (size_t)e * D * FFE;
        if (r < 896) { xpose_item_fp8(ap->in[I_M1] + (size_t)e * D * FFE, FFE, gf, W13_SCALE, w13, D, r / 56, r % 56, 256, 0, scr, lane); return; } r -= 896;
        if (r < 896) { xpose_item_fp8(ap->in[I_M3] + (size_t)e * D * FFE, FFE, gf, W13_SCALE, w13, D, r / 56, r % 56, 256, 128, scr, lane); return; } r -= 896;
        xpose_item_fp8(ap->in[I_M2] + (size_t)e * FFE * D, D, nullptr, W2_SCALE, w2, FFE, r >> 4, r & 15, 128, 0, scr, lane); }
}
constexpr int FL_WO0 = 256;
constexpr int FL_FFN = FL_WO0 + IT_FFN, FL_L1 = FL_FFN + IT_LAYER, FL_W13 = FL_L1 + NE * 1792, FL_TOTAL = FL_W13 + NE * 896;
__device__ __forceinline__ int filler_item(int i) {
    if (i < FL_WO0) return IT_LAYER - FL_WO0 + i;
    if (i < FL_FFN) return 2 * IT_LAYER + (i - FL_WO0);
    if (i < FL_L1) return IT_LAYER + (i - FL_FFN);
    if (i < FL_W13) { const int r = i - FL_L1, e = r / 1792; return 2 * IT_LAYER + IT_FFN + e * IT_EXP + (r - e * 1792); }
    const int r = i - FL_W13, e = r / 896; return 2 * IT_LAYER + IT_FFN + e * IT_EXP + 1792 + (r - e * 896);
}
struct CvtDesc { const float* W; int ldw; const float* g; float sc; unsigned char* WT; int Kd; int kb, nb, blk, off, f8; };
__device__ __forceinline__ void item_desc(ArgP ap, unsigned char* ws, int it, CvtDesc& d) {
    int r = it;
    if (r < 2 * IT_LAYER) { const int l = r / IT_LAYER; r -= l * IT_LAYER;
        const float* win = ap->in[I_WIN] + (size_t)l * D * NIN; const float* gm = ap->in[I_GMIX] + l * D;
        bf16_t* wint = (bf16_t*)(ws + WS_WIN) + (size_t)l * NIN * D; bf16_t* wcs = (bf16_t*)(ws + WS_WCS) + (size_t)l * 2048 * D; bf16_t* wot = (bf16_t*)(ws + WS_WO) + (size_t)l * D * D;
        if (r < 256) { d = CvtDesc{win, NIN, gm, 1.0f, (unsigned char*)(wint), D, r >> 4, r & 15, 256, 0, 0}; return; } r -= 256;
        if (r < 256) { d = CvtDesc{win + 1024, NIN, gm, 1.0f, (unsigned char*)(wint), D, r >> 4, r & 15, 256, 128, 0}; return; } r -= 256;
        if (r < 512) { d = CvtDesc{win + 2048, NIN, gm, 1.0f, (unsigned char*)(wint), D, r >> 5, r & 31, 128, 2048, 0}; return; } r -= 512;
        if (r < 256) { d = CvtDesc{win + 4096, NIN, gm, 1.0f, (unsigned char*)(wint), D, r >> 4, r & 15, 256, 4096, 0}; return; } r -= 256;
        if (r < 256) { d = CvtDesc{win + 5120, NIN, gm, 1.0f, (unsigned char*)(wint), D, r >> 4, r & 15, 256, 4096 + 128, 0}; return; } r -= 256;
        if (r < 256) { d = CvtDesc{ap->in[I_WCO] + (size_t)l * D * D, D, nullptr, 1.0f, (unsigned char*)(wcs), D, r >> 4, r & 15, 128, 0, 0}; return; } r -= 256;
        if (r < 256) { d = CvtDesc{ap->in[I_WSO] + (size_t)l * D * D, D, nullptr, 1.0f, (unsigned char*)(wcs), D, r >> 4, r & 15, 128, 1024, 0}; return; } r -= 256;
        d = CvtDesc{ap->in[I_WO] + (size_t)l * D * D, D, nullptr, 1.0f, (unsigned char*)(wot), D, r >> 4, r & 15, 128, 0, 0}; return; }
    r -= 2 * IT_LAYER;
    if (r < IT_FFN) { const float* gf = ap->in[I_GFFN];
        if (r < 704) { d = CvtDesc{ap->in[I_F1], FFD, gf, 1.0f, (unsigned char*)((bf16_t*)(ws + WS_WF13)), D, r / 44, r % 44, 256, 0, 0}; return; } r -= 704;
        if (r < 704) { d = CvtDesc{ap->in[I_F3], FFD, gf, 1.0f, (unsigned char*)((bf16_t*)(ws + WS_WF13)), D, r / 44, r % 44, 256, 128, 0}; return; } r -= 704;
        if (FFN_DOWN_FP8) d = CvtDesc{ap->in[I_F2], D, nullptr, (float)(W2_SCALE), (unsigned char*)(ws + WS_WF2), FFD, r >> 4, r & 15, 128, 0, 1};
        else d = CvtDesc{ap->in[I_F2], D, nullptr, 1.0f, (unsigned char*)((bf16_t*)(ws + WS_WF2)), FFD, r >> 4, r & 15, 128, 0, 0};
        return; }
    r -= IT_FFN;
    { const int e = r / IT_EXP; r -= e * IT_EXP; const float* gf = ap->in[I_GFFN] + D;
        unsigned char* w13 = ws + WS_WM13 + (size_t)e * 2 * FFE * D; unsigned char* w2 = ws + WS_WM2 + (size_t)e * D * FFE;
        if (r < 896) { d = CvtDesc{ap->in[I_M1] + (size_t)e * D * FFE, FFE, gf, (float)(W13_SCALE), (unsigned char*)(w13), D, r / 56, r % 56, 256, 0, 1}; return; } r -= 896;
        if (r < 896) { d = CvtDesc{ap->in[I_M3] + (size_t)e * D * FFE, FFE, gf, (float)(W13_SCALE), (unsigned char*)(w13), D, r / 56, r % 56, 256, 128, 1}; return; } r -= 896;
        d = CvtDesc{ap->in[I_M2] + (size_t)e * FFE * D, D, nullptr, (float)(W2_SCALE), (unsigned char*)(w2), FFE, r >> 4, r & 15, 128, 0, 1}; }
}
__device__ __forceinline__ void xpose_finish(const float (&v)[64], const CvtDesc& d, LAS float* scr, int lane) {
    const int k0 = 64 * d.kb, n0 = 64 * d.nb;
    if (d.g) {
#pragma unroll
        for (int i = 0; i < 64; ++i) scr[i * 65 + lane] = v[i] * (d.g[k0 + i] * d.sc);
    } else {
#pragma unroll
        for (int i = 0; i < 64; ++i) scr[i * 65 + lane] = v[i] * d.sc;
    }
    asm volatile("s_waitcnt lgkmcnt(0)" ::: "memory");
    const int c = lane & 7;
#pragma unroll
    for (int j = 0; j < 8; ++j) { const int n = (lane >> 3) + 8 * j, nn = n0 + n; const LAS float* s = scr + (8 * c) * 65 + n; const size_t row = (size_t)((nn >> 7) * d.blk + (nn & 127) + d.off);
        if (d.f8) *(u32x2*)(d.WT + row * d.Kd + k0 + 8 * c) = pack8_fp8((f32x4){s[0 * 65], s[1 * 65], s[2 * 65], s[3 * 65]}, (f32x4){s[4 * 65], s[5 * 65], s[6 * 65], s[7 * 65]});
        else { u32x4 o; o.x = cvt_pk_bf16(s[0 * 65], s[1 * 65]); o.y = cvt_pk_bf16(s[2 * 65], s[3 * 65]); o.z = cvt_pk_bf16(s[4 * 65], s[5 * 65]); o.w = cvt_pk_bf16(s[6 * 65], s[7 * 65]);
               *(u32x4*)((bf16_t*)d.WT + row * d.Kd + k0 + 8 * c) = o; } }
    asm volatile("s_waitcnt lgkmcnt(0)" ::: "memory");
}
__device__ __forceinline__ void convert_pair(ArgP ap, unsigned char* ws, int itA, int itB, LAS float* scr, int lane) {
    CvtDesc da, db; item_desc(ap, ws, itA, da); item_desc(ap, ws, itB, db);
    const float* sa = da.W + (size_t)(64 * da.kb) * da.ldw + 64 * da.nb + lane; const float* sb = db.W + (size_t)(64 * db.kb) * db.ldw + 64 * db.nb + lane;
    float va[64], vb[64];
#pragma unroll
    for (int i = 0; i < 64; ++i) va[i] = __builtin_nontemporal_load(sa + (size_t)i * da.ldw);
#pragma unroll
    for (int i = 0; i < 64; ++i) vb[i] = __builtin_nontemporal_load(sb + (size_t)i * db.ldw);
    xpose_finish(va, da, scr, lane);
    xpose_finish(vb, db, scr, lane);
}
__device__ __forceinline__ bool moe13_desc(ArgP ap, unsigned char* ws, int it, const float*& W, unsigned char*& WT, int& kb, int& nb, int& off) {
    int r = it - (2 * IT_LAYER + IT_FFN); if (r < 0) return false;
    const int e = r / IT_EXP; r -= e * IT_EXP; if (r >= 1792) return false;
    const int w3 = r >= 896 ? 1 : 0; r -= 896 * w3;
    W = ap->in[w3 ? I_M3 : I_M1] + (size_t)e * D * FFE; WT = ws + WS_WM13 + (size_t)e * 2 * FFE * D; kb = r / 56; nb = r % 56; off = 128 * w3; return true;
}
__device__ __forceinline__ void fp8_finish13(const float (&v)[64], const float* g, unsigned char* WT, int kb, int nb, int off, LAS float* scr, int lane) {
    const int k0 = 64 * kb, n0 = 64 * nb;
#pragma unroll
    for (int i = 0; i < 64; ++i) scr[i * 65 + lane] = v[i] * (g[k0 + i] * (float)W13_SCALE);
    asm volatile("s_waitcnt lgkmcnt(0)" ::: "memory");
    const int c = lane & 7;
#pragma unroll
    for (int j = 0; j < 8; ++j) { const int n = (lane >> 3) + 8 * j, nn = n0 + n; const LAS float* s = scr + (8 * c) * 65 + n;
        *(u32x2*)(WT + (size_t)((nn >> 7) * 256 + (nn & 127) + off) * D + k0 + 8 * c) = pack8_fp8((f32x4){s[0 * 65], s[1 * 65], s[2 * 65], s[3 * 65]}, (f32x4){s[4 * 65], s[5 * 65], s[6 * 65], s[7 * 65]}); }
    asm volatile("s_waitcnt lgkmcnt(0)" ::: "memory");
}
__device__ __forceinline__ void convert_pair13(ArgP ap, unsigned char* ws, int itA, int itB, LAS float* scr, int lane) {
    const float* Wa; const float* Wb; unsigned char* Ta; unsigned char* Tb; int kba, nba, offa, kbb, nbb, offb;
    if (!moe13_desc(ap, ws, itA, Wa, Ta, kba, nba, offa) || !moe13_desc(ap, ws, itB, Wb, Tb, kbb, nbb, offb)) { convert_item(ap, ws, itA, scr, lane); convert_item(ap, ws, itB, scr, lane); return; }
    const float* g = ap->in[I_GFFN] + D;
    const float* sa = Wa + (size_t)(64 * kba) * FFE + 64 * nba + lane; const float* sb = Wb + (size_t)(64 * kbb) * FFE + 64 * nbb + lane;
    float va[64], vb[64];
#pragma unroll
    for (int i = 0; i < 64; ++i) va[i] = __builtin_nontemporal_load(sa + (size_t)i * FFE);
#pragma unroll
    for (int i = 0; i < 64; ++i) vb[i] = __builtin_nontemporal_load(sb + (size_t)i * FFE);
    fp8_finish13(va, g, Ta, kba, nba, offa, scr, lane);
    fp8_finish13(vb, g, Tb, kbb, nbb, offb, scr, lane);
}
template <int PART> __device__ __forceinline__ void prologue_phase(ArgP ap, LAS unsigned char* lds, int G, int c, int tid, int wid, int lane) {
    unsigned char* ws = ap->ws;
    LAS float* scr = (LAS float*)(lds + wid * 16640);
    const int gw = c * 8 + wid, NGW = G * 8;
    constexpr int IT_LO = PART == 0 ? 0 : IT_LAYER - FL_WO0, IT_HI = PART == 0 ? IT_LAYER - FL_WO0 : IT_TOTAL;
    if constexpr (PART != 0) { for (int it = IT_LO + gw; it < IT_HI; it += NGW) convert_item(ap, ws, it, scr, lane); }
    if constexpr (PART == 0) {
    const float* x = ap->in[I_X]; bf16_t* xb = (bf16_t*)(ws + WS_XB); float* ssq = (float*)(ws + WS_SSQ);
    f32x4 xv[8][4];
#pragma unroll
    for (int j = 0; j < 8; ++j) { const int m = gw + NGW * j; const f32x4* xr = (const f32x4*)(x + (size_t)(m < T ? m : 0) * D) + lane;
#pragma unroll
        for (int q = 0; q < 4; ++q) xv[j][q] = __builtin_nontemporal_load(xr + 64 * q); }
    for (int it = IT_LO + gw; it < IT_HI; it += NGW) convert_item(ap, ws, it, scr, lane);
#pragma unroll
    for (int j = 0; j < 8; ++j) { const int m = gw + NGW * j; if (m < T) { u32x2* o8 = (u32x2*)(xb + (size_t)m * D) + lane; float s = 0.f;
#pragma unroll
        for (int q = 0; q < 4; ++q) { const f32x4 v = xv[j][q]; s += (v[0] * v[0] + v[1] * v[1]) + (v[2] * v[2] + v[3] * v[3]); u32x2 w; w.x = cvt_pk_bf16(v[0], v[1]); w.y = cvt_pk_bf16(v[2], v[3]); o8[64 * q] = w; }
        s = wave_sum(s);
        if (lane < 4) ssq[(size_t)lane * T + m] = lane == 0 ? s : 0.f; } }
    { for (int m = gw + NGW * 8; m < T; m += NGW) { const f32x4* xr = (const f32x4*)(x + (size_t)m * D) + lane; u32x2* o8 = (u32x2*)(xb + (size_t)m * D) + lane; float s = 0.f;
#pragma unroll
            for (int j = 0; j < 4; ++j) { const f32x4 v = xr[64 * j]; s += (v[0] * v[0] + v[1] * v[1]) + (v[2] * v[2] + v[3] * v[3]); u32x2 w; w.x = cvt_pk_bf16(v[0], v[1]); w.y = cvt_pk_bf16(v[2], v[3]); o8[64 * j] = w; }
            s = wave_sum(s);
            if (lane < 4) ssq[(size_t)lane * T + m] = lane == 0 ? s : 0.f; } }
    { const float* cwsrc = ap->in[I_CONVW]; float* o = (float*)(ws + WS_CWT);
        for (int i = c * 512 + tid; i < 2 * D * 32; i += G * 512) { const int k = i & 31, ch = (i >> 5) & (D - 1), l = i >> 15; o[i] = k < CK ? cwsrc[((size_t)l * CK + k) * D + ch] : 0.f; } }
    { const float* sw = ap->in[I_SGW]; bf16_t* o = (bf16_t*)(ws + WS_SGW);
        for (int i = c * 512 + tid; i < 2 * 8 * 128 * 16; i += G * 512) { const int t = (i >> 4) & 127, s0 = (i & 15) * 8; const f32x4 a = *(const f32x4*)(sw + (size_t)i * 8), b = *(const f32x4*)(sw + (size_t)i * 8 + 4);
            float v[8] = {a[0], a[1], a[2], a[3], b[0], b[1], b[2], b[3]};
#pragma unroll
            for (int j = 0; j < 8; ++j) v[j] = (s0 + j <= t) ? v[j] : 0.f;
            *(u32x4*)(o + (size_t)i * 8) = pack8((f32x4){v[0], v[1], v[2], v[3]}, (f32x4){v[4], v[5], v[6], v[7]}); } }
    }
}

constexpr int FILL_BARRIERS = 12, FILL_WAVES = 7, FILL_PER_WAVE = (FL_TOTAL + 256 * FILL_WAVES - 1) / (256 * FILL_WAVES);
__device__ __forceinline__ int fill_min(int seq) { return seq < 3 ? 2 * seq + 1 : (seq < 6 ? seq + 3 : seq + 4); }
static_assert(FILL_PER_WAVE == 15, "filler list");
__device__ __forceinline__ void xcd_barrier_fill(const XcdBarrier& b, ArgP ap, unsigned char* ws, LAS unsigned char* lds, volatile LAS unsigned* relw, int seq, int c, int wid, int lane, int& fdone) {
    asm volatile("s_waitcnt vmcnt(0)" ::: "memory");
    __syncthreads();
    if (wid == 0) {
        if (threadIdx.x == 0) {
            unsigned* bar = b.bar;
            __builtin_amdgcn_s_waitcnt(0);
            unsigned nloc = b.st[0], nx = b.st[1];
            if (nloc == 0u) { xcd_barrier_complete(bar, b.x, nloc, nx); b.st[0] = nloc; b.st[1] = nx; }
            const unsigned old = xb_add(&bar[XB_XSUB(b.x)], 1u);
            const unsigned gen = old / nloc;
            if (old + 1u == (gen + 1u) * nloc) {
                __builtin_amdgcn_fence(__ATOMIC_RELEASE, "agent");
                asm volatile("s_waitcnt vmcnt(0)" ::: "memory");
                const unsigned og = xb_add(&bar[XB_TOP], 1u);
                const unsigned tg = og / nx;
                if (og + 1u == (tg + 1u) * nx) xb_add(&bar[XB_TOPGEN], 1u);
                else XB_SPIN(xb_ld(&bar[XB_TOPGEN]) == tg, bar);
                __builtin_amdgcn_fence(__ATOMIC_ACQUIRE, "agent");
                xb_add(&bar[XB_XGEN(b.x)], 1u);
                asm volatile("s_waitcnt vmcnt(0)" ::: "memory");
            } else {
                XB_SPIN(xb_ld(&bar[XB_XGEN(b.x)]) == gen, bar);
                __builtin_amdgcn_fence(__ATOMIC_ACQUIRE, "agent");
                asm volatile("s_waitcnt vmcnt(0)" ::: "memory");
            }
            *relw = (unsigned)seq + 1u;
        }
    } else {
        LAS float* scr = (LAS float*)(lds + (wid - 1) * 16640);
        const int fw = c * FILL_WAVES + (wid - 1), need = fill_min(seq);
        int done = fdone;
        const bool deleg = FILL_DELEGATE && gridDim.x == 256;
        if (deleg && seq == 5 && c >= 128) {
            for (int jj = 0; jj < 2; ++jj) { const int j = 7 + jj, ip = fw - 128 * FILL_WAVES + 256 * FILL_WAVES * j;
                if (done <= j) { done = j + 1; convert_pair13(ap, ws, filler_item(fw + 256 * FILL_WAVES * j), filler_item(ip), scr, lane); }
                else convert_item(ap, ws, filler_item(ip), scr, lane); }
        }
        while (done < FILL_PER_WAVE) {
            if (deleg && c < 128 && (done == 7 || done == 8)) { ++done; continue; }
            if (done >= need && (unsigned)__builtin_amdgcn_readfirstlane((int)*relw) == (unsigned)seq + 1u) break;
            const int i = fw + 256 * FILL_WAVES * done;
            if (PAIR_REQUIRED && need - done >= 2 && i + 256 * FILL_WAVES < FL_TOTAL && !(deleg && c < 128 && done + 1 >= 7 && done + 1 <= 8)) {
                convert_pair(ap, ws, filler_item(i), filler_item(i + 256 * FILL_WAVES), scr, lane); done += 2; continue; }
            if (i < FL_TOTAL) convert_item(ap, ws, filler_item(i), scr, lane);
            ++done;
        }
        fdone = done;
    }
    asm volatile("s_waitcnt lgkmcnt(0)" ::: "memory"); __builtin_amdgcn_s_barrier(); asm volatile("" ::: "memory");
}

template <int J, int ROT> __device__ __forceinline__ void conv_row(f32x2 (&acc)[32], const f32x2 (&w)[32], LAS unsigned char* p) {
    constexpr int LO = J - 30 > 0 ? J - 30 : 0, HI = J < 31 ? J : 31, SLOT = (J + ROT) % 62;
    const unsigned raw = *(const LAS unsigned*)(p + SLOT * 2048); const f32x2 v = (f32x2){bf_lo(raw), bf_hi(raw)};
#pragma unroll
    for (int i = LO; i <= HI; ++i) acc[i] += w[J - i] * v;
    if constexpr ((J & 3) == 3) __builtin_amdgcn_sched_barrier(0);
}
template <int ROT, int... Js> __device__ __forceinline__ void conv_rows(f32x2 (&acc)[32], const f32x2 (&w)[32], LAS unsigned char* p, std::integer_sequence<int, Js...>) { (conv_row<Js, ROT>(acc, w, p), ...); }
__device__ __forceinline__ void conv_ln_store(LAS unsigned char* lds, f32x2 (&acc)[32], bf16_t* Cp, int t0, f32x2 g2, f32x2 b2, int tid, int wid, int lane) {
    float tot[2];
#pragma unroll
    for (int pass = 0; pass < 2; ++pass) {
        float val[32];
#pragma unroll
        for (int i = 0; i < 32; ++i) val[i] = pass == 0 ? acc[i].x + acc[i].y : acc[i].x * acc[i].x + acc[i].y * acc[i].y;
#pragma unroll
        for (int h = 16; h >= 1; h >>= 1) { const bool up = (lane & h) != 0;
#pragma unroll
            for (int k = 0; k < h; ++k) { const float lo = val[k], hi = val[k + h]; const float send = up ? lo : hi, keep = up ? hi : lo; val[k] = keep + __shfl_xor(send, h); } }
        tot[pass] = val[0] + __shfl_xor(val[0], 32);
    }
    LAS float* red = (LAS float*)(lds + 62 * 2048); LAS f32x2* stat = (LAS f32x2*)(lds + 62 * 2048 + 2048);
    red[wid * 64 + lane] = lane < 32 ? tot[0] : tot[1];
    asm volatile("s_waitcnt lgkmcnt(0)" ::: "memory"); __builtin_amdgcn_s_barrier(); asm volatile("" ::: "memory");
    if (tid < 32) { float s1 = 0.f, s2 = 0.f;
#pragma unroll
        for (int wv = 0; wv < 8; ++wv) { s1 += red[wv * 64 + tid]; s2 += red[wv * 64 + 32 + tid]; }
        const float mean = s1 * (1.0f / D), var = s2 * (1.0f / D) - mean * mean; stat[tid] = (f32x2){mean, __builtin_amdgcn_rsqf(var + EPS)}; }
    asm volatile("s_waitcnt lgkmcnt(0)" ::: "memory"); __builtin_amdgcn_s_barrier(); asm volatile("" ::: "memory");
    unsigned* outp = (unsigned*)(Cp + (size_t)t0 * D) + tid;
#pragma unroll
    for (int i = 0; i < 32; ++i) { const f32x2 st = stat[i]; const f32x2 y = (acc[i] - st.x) * st.y * g2 + b2; outp[(size_t)i * (D / 2)] = cvt_pk_bf16(siluf_(y.x), siluf_(y.y)); }
}
__device__ __forceinline__ void conv_load_w(f32x2 (&w)[32], const float* cw, int tid) {
    const f32x4* w0 = (const f32x4*)(cw + (size_t)(2 * tid) * 32); const f32x4* w1 = w0 + 8;
#pragma unroll
    for (int k4 = 0; k4 < 8; ++k4) { const f32x4 a = w0[k4], b = w1[k4];
#pragma unroll
        for (int i = 0; i < 4; ++i) w[4 * k4 + i] = (f32x2){a[i], b[i]}; }
}
__device__ __forceinline__ void conv_span(LAS unsigned char* lds, int span, const bf16_t* Ap, bf16_t* Cp, const float* cw, const float* cb, const float* lng, const float* lnb, int tid, int wid, int lane) {
    asm volatile("" : "+v"(tid));
    const int t0 = span * 64, s0 = t0 & (SEQ - 1);
    for (int q = wid; q < 124; q += 8) { const int j = q >> 1, hf = q & 1;
        if (s0 + j >= 30) __builtin_amdgcn_global_load_lds((const unsigned*)(Ap + (size_t)(t0 - 30 + j) * D + hf * 512 + lane * 8), (LAS unsigned*)(lds + j * 2048 + hf * 1024), 16, 0, 0);
        else *(LAS u32x4*)(lds + j * 2048 + hf * 1024 + lane * 16) = (u32x4){0u, 0u, 0u, 0u}; }
    f32x2 w[32];
    conv_load_w(w, cw, tid);
    const f32x2 bias = *(const f32x2*)(cb + 2 * tid), g2 = *(const f32x2*)(lng + 2 * tid), b2 = *(const f32x2*)(lnb + 2 * tid);
    asm volatile("s_waitcnt vmcnt(0) lgkmcnt(0)" ::: "memory"); __builtin_amdgcn_s_barrier(); asm volatile("" ::: "memory");
    f32x2 acc[32];
#pragma unroll
    for (int i = 0; i < 32; ++i) acc[i] = bias;
    conv_rows<0>(acc, w, lds + tid * 4, std::make_integer_sequence<int, 62>{});
    asm volatile("s_waitcnt lgkmcnt(0)" ::: "memory"); __builtin_amdgcn_s_barrier(); asm volatile("" ::: "memory");
    for (int q = wid; q < 64; q += 8) { const int j = q >> 1, hf = q & 1;
        __builtin_amdgcn_global_load_lds((const unsigned*)(Ap + (size_t)(t0 + 32 + j) * D + hf * 512 + lane * 8), (LAS unsigned*)(lds + j * 2048 + hf * 1024), 16, 0, 0); }
    conv_ln_store(lds, acc, Cp, t0, g2, b2, tid, wid, lane);
    f32x2 w2[32];
    conv_load_w(w2, cw, tid);
    asm volatile("s_waitcnt vmcnt(0) lgkmcnt(0)" ::: "memory"); __builtin_amdgcn_s_barrier(); asm volatile("" ::: "memory");
#pragma unroll
    for (int i = 0; i < 32; ++i) acc[i] = bias;
    conv_rows<32>(acc, w2, lds + tid * 4, std::make_integer_sequence<int, 62>{});
    conv_ln_store(lds, acc, Cp, t0 + 32, g2, b2, tid, wid, lane);
    asm volatile("s_waitcnt lgkmcnt(0)" ::: "memory"); __builtin_amdgcn_s_barrier(); asm volatile("" ::: "memory");
}

__device__ __forceinline__ unsigned off_b(unsigned row, unsigned ch) { return 256u * row + 16u * (ch ^ (((row & 3) << 2) | ((row >> 2) & 3))); }
__device__ __forceinline__ unsigned tr_read_addr_16(unsigned lane, unsigned cb, unsigned ks, unsigned t) { const unsigned g = lane >> 4, q = (lane & 15) >> 2, p = lane & 3; return off_b(32 * ks + 8 * g + 4 * t + q, 2 * cb + (p >> 1)) + 8 * (p & 1); }
__device__ __forceinline__ void sgu_load_gv(u32x4 (&raw)[4], const bf16_t* GV, int unit, int tid) {
    const int g = unit & 7, bn = unit >> 3, ch = tid & 15;
#pragma unroll
    for (int k = 0; k < 4; ++k) raw[k] = *(const u32x4*)(GV + (size_t)(bn * CHUNK + (tid >> 4) + 32 * k) * D + g * 128 + 8 * ch);
}
__device__ __forceinline__ void sgu_phase(LAS unsigned char* lds, int c, int G, const bf16_t* GV, const bf16_t* GU, bf16_t* Y, const float* lng, const float* lnb, const bf16_t* Wm, const float* sgb, int tid, int wid, int lane) {
    constexpr int NU = (T / CHUNK) * 8;
    const int fr = lane & 15, fq = lane >> 4, ch = tid & 15;
    u32x4 raw[4];
    if (c < NU) sgu_load_gv(raw, GV, c, tid);
    for (int unit = c; unit < NU; unit += G) {
        const int g = unit & 7, bn = unit >> 3, t0 = bn * CHUNK, c0 = g * 128, t = 16 * wid + fr;
        const f32x4 ga = *(const f32x4*)(lng + c0 + 8 * ch), gb = *(const f32x4*)(lng + c0 + 8 * ch + 4), ba = *(const f32x4*)(lnb + c0 + 8 * ch), bb = *(const f32x4*)(lnb + c0 + 8 * ch + 4);
        const bf16_t* wrow = Wm + ((size_t)g * 128 + t) * 128 + 8 * fq;
        bf16x8 bfrag[4];
#pragma unroll
        for (int ks = 0; ks < 4; ++ks) bfrag[ks] = *(const bf16x8*)(wrow + 32 * ks);
        u32x2 gu[8];
#pragma unroll
        for (int cb = 0; cb < 8; ++cb) gu[cb] = *(const u32x2*)(GU + (size_t)(t0 + t) * D + c0 + 16 * cb + 4 * fq);
        const float bias = sgb[g * 128 + t];
#pragma unroll
        for (int k = 0; k < 4; ++k) { const int s = (tid >> 4) + 32 * k; const f32x4 a = unpk_lo(raw[k]), b = unpk_hi(raw[k]);
            float sum = (a[0] + a[1]) + (a[2] + a[3]) + (b[0] + b[1]) + (b[2] + b[3]);
            float sq = (a[0] * a[0] + a[1] * a[1]) + (a[2] * a[2] + a[3] * a[3]) + (b[0] * b[0] + b[1] * b[1]) + (b[2] * b[2] + b[3] * b[3]);
#pragma unroll
            for (int o = 1; o < 16; o <<= 1) { sum += __shfl_xor(sum, o); sq += __shfl_xor(sq, o); }
            const float mean = sum * (1.0f / 128.0f), var = sq * (1.0f / 128.0f) - mean * mean, rstd = __builtin_amdgcn_rsqf(var + EPS);
            const f32x4 ya = (a - mean) * rstd * ga + ba, yb = (b - mean) * rstd * gb + bb;
            *(LAS u32x4*)(lds + off_b(s, ch)) = pack8(ya, yb); }
        if (unit + G < NU) sgu_load_gv(raw, GV, unit + G, tid);
        __syncthreads();
        f32x4 acc[8];
#pragma unroll
        for (int cb = 0; cb < 8; ++cb) acc[cb] = (f32x4){0.f, 0.f, 0.f, 0.f};
        const int nks = (wid >> 1) + 1;
#pragma unroll
        for (int ks = 0; ks < 4; ++ks) if (ks < nks) {
#pragma unroll
            for (int cb = 0; cb < 8; ++cb) { const bf16x4 lo = __builtin_amdgcn_ds_read_tr16_b64_v4i16((LAS bf16x4*)(lds + tr_read_addr_16(lane, cb, ks, 0))), hi = __builtin_amdgcn_ds_read_tr16_b64_v4i16((LAS bf16x4*)(lds + tr_read_addr_16(lane, cb, ks, 1)));
                const bf16x8 afrag = (bf16x8){lo[0], lo[1], lo[2], lo[3], hi[0], hi[1], hi[2], hi[3]};
                acc[cb] = __builtin_amdgcn_mfma_f32_16x16x32_bf16(afrag, bfrag[ks], acc[cb], 0, 0, 0); } }
#pragma unroll
        for (int cb = 0; cb < 8; ++cb) { u32x2 o; o.x = cvt_pk_bf16(bf_lo(gu[cb].x) * (acc[cb][0] + bias), bf_hi(gu[cb].x) * (acc[cb][1] + bias)); o.y = cvt_pk_bf16(bf_lo(gu[cb].y) * (acc[cb][2] + bias), bf_hi(gu[cb].y) * (acc[cb][3] + bias));
            *(u32x2*)(Y + (size_t)(t0 + t) * D + c0 + 16 * cb + 4 * fq) = o; }
        __syncthreads();
    }
}

struct SguRegs { u32x4 raw[4]; };
__device__ __forceinline__ void sgu_issue(SguRegs& r, int unit, const bf16_t* GV, const bf16_t* GU, int tid, int wid, int lane) {
    const int fr = lane & 15, fq = lane >> 4, g = unit & 7, bn = unit >> 3, t0 = bn * CHUNK, c0 = g * 128, t = 16 * wid + fr;
    sgu_load_gv(r.raw, GV, unit, tid); (void)GU; (void)fq; (void)t0; (void)c0; (void)t;
}
__device__ __forceinline__ void sgu_finish(LAS unsigned char* lds, const SguRegs& r, int unit, const bf16_t* GU, bf16_t* Y, const float* lng, const float* lnb, const bf16_t* Wm, const float* sgb, int tid, int wid, int lane) {
    const int fr = lane & 15, fq = lane >> 4, ch = tid & 15, g = unit & 7, bn = unit >> 3, t0 = bn * CHUNK, c0 = g * 128, t = 16 * wid + fr;
    const f32x4 ga = *(const f32x4*)(lng + c0 + 8 * ch), gb = *(const f32x4*)(lng + c0 + 8 * ch + 4), ba = *(const f32x4*)(lnb + c0 + 8 * ch), bb = *(const f32x4*)(lnb + c0 + 8 * ch + 4);
    const bf16_t* wrow = Wm + ((size_t)g * 128 + t) * 128 + 8 * fq;
    bf16x8 bfrag[4];
#pragma unroll
    for (int ks = 0; ks < 4; ++ks) bfrag[ks] = *(const bf16x8*)(wrow + 32 * ks);
    const float bias = sgb[g * 128 + t];
    u32x2 gu[8];
#pragma unroll
    for (int cb = 0; cb < 8; ++cb) gu[cb] = *(const u32x2*)(GU + (size_t)(t0 + t) * D + c0 + 16 * cb + 4 * fq);
#pragma unroll
    for (int k = 0; k < 4; ++k) { const int sr = (tid >> 4) + 32 * k; const f32x4 a = unpk_lo(r.raw[k]), b = unpk_hi(r.raw[k]);
        float sum = (a[0] + a[1]) + (a[2] + a[3]) + (b[0] + b[1]) + (b[2] + b[3]);
        float sq = (a[0] * a[0] + a[1] * a[1]) + (a[2] * a[2] + a[3] * a[3]) + (b[0] * b[0] + b[1] * b[1]) + (b[2] * b[2] + b[3] * b[3]);
#pragma unroll
        for (int o = 1; o < 16; o <<= 1) { sum += __shfl_xor(sum, o); sq += __shfl_xor(sq, o); }
        const float mean = sum * (1.0f / 128.0f), var = sq * (1.0f / 128.0f) - mean * mean, rstd = __builtin_amdgcn_rsqf(var + EPS);
        const f32x4 ya = (a - mean) * rstd * ga + ba, yb = (b - mean) * rstd * gb + bb;
        *(LAS u32x4*)(lds + off_b(sr, ch)) = pack8(ya, yb); }
    asm volatile("s_waitcnt lgkmcnt(0)" ::: "memory"); __builtin_amdgcn_s_barrier(); asm volatile("" ::: "memory");
    f32x4 acc[8];
#pragma unroll
    for (int cb = 0; cb < 8; ++cb) acc[cb] = (f32x4){0.f, 0.f, 0.f, 0.f};
    const int nks = (wid >> 1) + 1;
#pragma unroll
    for (int ks = 0; ks < 4; ++ks) if (ks < nks) {
#pragma unroll
        for (int cb = 0; cb < 8; ++cb) { const bf16x4 lo = __builtin_amdgcn_ds_read_tr16_b64_v4i16((LAS bf16x4*)(lds + tr_read_addr_16(lane, cb, ks, 0))), hi = __builtin_amdgcn_ds_read_tr16_b64_v4i16((LAS bf16x4*)(lds + tr_read_addr_16(lane, cb, ks, 1)));
            const bf16x8 afrag = (bf16x8){lo[0], lo[1], lo[2], lo[3], hi[0], hi[1], hi[2], hi[3]};
            acc[cb] = __builtin_amdgcn_mfma_f32_16x16x32_bf16(afrag, bfrag[ks], acc[cb], 0, 0, 0); } }
#pragma unroll
    for (int cb = 0; cb < 8; ++cb) { u32x2 o; o.x = cvt_pk_bf16(bf_lo(gu[cb].x) * (acc[cb][0] + bias), bf_hi(gu[cb].x) * (acc[cb][1] + bias)); o.y = cvt_pk_bf16(bf_lo(gu[cb].y) * (acc[cb][2] + bias), bf_hi(gu[cb].y) * (acc[cb][3] + bias));
        *(u32x2*)(Y + (size_t)(t0 + t) * D + c0 + 16 * cb + 4 * fq) = o; }
    asm volatile("s_waitcnt lgkmcnt(0)" ::: "memory"); __builtin_amdgcn_s_barrier(); asm volatile("" ::: "memory");
}
__device__ __forceinline__ void mix_fused(LAS unsigned char* lds, int span, int u0, int G, const bf16_t* Ap, bf16_t* Cp, const float* cw, const float* cb, const float* lng, const float* lnb,
                                          const bf16_t* GV, const bf16_t* GU, bf16_t* Y, const float* slng, const float* slnb, const bf16_t* Wm, const float* sgb, int tid, int wid, int lane) {
    constexpr int NU = (T / CHUNK) * 8;
    LAS unsigned char* cl = lds + 32768;
    SguRegs ra;
    int unit = u0;
    sgu_issue(ra, unit, GV, GU, tid, wid, lane);
    const int t0 = span * 64, s0 = t0 & (SEQ - 1);
    for (int q = wid; q < 124; q += 8) { const int j = q >> 1, hf = q & 1;
        if (s0 + j >= 30) __builtin_amdgcn_global_load_lds((const unsigned*)(Ap + (size_t)(t0 - 30 + j) * D + hf * 512 + lane * 8), (LAS unsigned*)(cl + j * 2048 + hf * 1024), 16, 0, 0);
        else *(LAS u32x4*)(cl + j * 2048 + hf * 1024 + lane * 16) = (u32x4){0u, 0u, 0u, 0u}; }
    f32x2 acc[32];
    { f32x2 w[32];
      conv_load_w(w, cw, tid);
      const f32x2 bias = *(const f32x2*)(cb + 2 * tid);
      asm volatile("s_waitcnt vmcnt(0) lgkmcnt(0)" ::: "memory"); __builtin_amdgcn_s_barrier(); asm volatile("" ::: "memory");
#pragma unroll
      for (int i = 0; i < 32; ++i) acc[i] = bias;
      conv_rows<0>(acc, w, cl + tid * 4, std::make_integer_sequence<int, 62>{}); }
    asm volatile("s_waitcnt lgkmcnt(0)" ::: "memory"); __builtin_amdgcn_s_barrier(); asm volatile("" ::: "memory");
    for (int q = wid; q < 64; q += 8) { const int j = q >> 1, hf = q & 1;
        __builtin_amdgcn_global_load_lds((const unsigned*)(Ap + (size_t)(t0 + 32 + j) * D + hf * 512 + lane * 8), (LAS unsigned*)(cl + j * 2048 + hf * 1024), 16, 0, 0); }
    __builtin_amdgcn_sched_barrier(0); conv_ln_store(cl, acc, Cp, t0, *(const f32x2*)(lng + 2 * tid), *(const f32x2*)(lnb + 2 * tid), tid, wid, lane);
    __builtin_amdgcn_sched_barrier(0); sgu_finish(lds, ra, unit, GU, Y, slng, slnb, Wm, sgb, tid, wid, lane);
    unit += G;
    { f32x2 w2[32];
      asm volatile("s_waitcnt vmcnt(0) lgkmcnt(0)" ::: "memory"); __builtin_amdgcn_s_barrier(); asm volatile("" ::: "memory");
      conv_load_w(w2, cw, tid);
      const f32x2 bias = *(const f32x2*)(cb + 2 * tid);
      if (unit < NU) sgu_issue(ra, unit, GV, GU, tid, wid, lane);
#pragma unroll
      for (int i = 0; i < 32; ++i) acc[i] = bias;
      conv_rows<32>(acc, w2, cl + tid * 4, std::make_integer_sequence<int, 62>{}); }
    __builtin_amdgcn_sched_barrier(0); conv_ln_store(cl, acc, Cp, t0 + 32, *(const f32x2*)(lng + 2 * tid), *(const f32x2*)(lnb + 2 * tid), tid, wid, lane);
    __builtin_amdgcn_sched_barrier(0);
    SguRegs rb;
    const int u1 = unit, u2 = unit + G, u3 = unit + 2 * G;
    if (u2 < NU) sgu_issue(rb, u2, GV, GU, tid, wid, lane);
    __builtin_amdgcn_sched_barrier(0); if (u1 < NU) sgu_finish(lds, ra, u1, GU, Y, slng, slnb, Wm, sgb, tid, wid, lane);
    __builtin_amdgcn_sched_barrier(0); if (u3 < NU) sgu_issue(ra, u3, GV, GU, tid, wid, lane);
    __builtin_amdgcn_sched_barrier(0); if (u2 < NU) sgu_finish(lds, rb, u2, GU, Y, slng, slnb, Wm, sgb, tid, wid, lane);
    __builtin_amdgcn_sched_barrier(0); if (u3 < NU) sgu_finish(lds, ra, u3, GU, Y, slng, slnb, Wm, sgb, tid, wid, lane);
}

__device__ __forceinline__ void route_phase(ArgP ap, LAS unsigned char* lds, unsigned* cntw, unsigned char* listb, int G, int c, int tid, int wid, int lane) {
    const float* plg = (const float*)((const bf16_t*)(ap->ws + WS_H) + 5 * PLANE); const float* ssq = (const float*)(ap->ws + WS_SSQ);
    int* rowtok = (int*)listb; float* rowgate = (float*)(listb + 512 * 1024); float* rowrs = (float*)(listb + 1024 * 1024);
    LAS int* s_lcnt = (LAS int*)lds; LAS int* s_gb = s_lcnt + 8;
    for (int blk = c; blk < T / 64; blk += G) {
        if (tid < 8) s_lcnt[tid] = 0;
        __syncthreads();
        int r0 = 0, r1 = 0, e0 = 0, e1 = 0; float w0 = 0.f, rs = 0.f; const int tok = blk * 64 + tid;
        if (tid < 64) { f32x4 la = (f32x4){0.f, 0.f, 0.f, 0.f}, lb = la; float ss = 0.f;
#pragma unroll
            for (int pn = 0; pn < 4; ++pn) { const float* q = plg + ((size_t)pn * T + tok) * 8; la += *(const f32x4*)q; lb += *(const f32x4*)(q + 4); ss += ssq[(size_t)pn * T + tok]; }
            rs = __builtin_amdgcn_rsqf(ss * (1.0f / D) + EPS);
            const float dot[8] = {la[0], la[1], la[2], la[3], lb[0], lb[1], lb[2], lb[3]};
            float bv = dot[0] * rs; int bi = 0;
#pragma unroll
            for (int e = 1; e < 8; ++e) { const float l = dot[e] * rs; if (l > bv) { bv = l; bi = e; } }
            float sv = -3.0e38f; int si = 0;
#pragma unroll
            for (int e = 0; e < 8; ++e) { const float l = dot[e] * rs; if (e != bi && l > sv) { sv = l; si = e; } }
            w0 = 1.0f / (1.0f + __expf(sv - bv)); e0 = bi; e1 = si;
            r0 = __hip_atomic_fetch_add(s_lcnt + e0, 1, __ATOMIC_RELAXED, __HIP_MEMORY_SCOPE_WORKGROUP); r1 = __hip_atomic_fetch_add(s_lcnt + e1, 1, __ATOMIC_RELAXED, __HIP_MEMORY_SCOPE_WORKGROUP); }
        __syncthreads();
        if (tid < 8) s_gb[tid] = (int)__hip_atomic_fetch_add(cntw + 64 * tid, (unsigned)s_lcnt[tid], __ATOMIC_RELAXED, __HIP_MEMORY_SCOPE_AGENT);
        __syncthreads();
        if (tid < 64) { const int i0 = e0 * 16384 + s_gb[e0] + r0, i1 = e1 * 16384 + s_gb[e1] + r1;
            rowtok[i0] = 2 * tok; rowgate[i0] = w0; rowrs[i0] = rs;
            rowtok[i1] = 2 * tok + 1; rowgate[i1] = 1.0f - w0; rowrs[i1] = rs; }
        __syncthreads();
    }
}
__device__ __forceinline__ MoeTiles moe_tiles(unsigned* ctl) {
    MoeTiles mt; int acc = 0;
#pragma unroll
    for (int e = 0; e < NE; ++e) { int cn = (int)__hip_atomic_load(ctl + CW_CNT + 64 * e, __ATOMIC_RELAXED, __HIP_MEMORY_SCOPE_AGENT); cn = cn < 0 ? 0 : (cn > T ? T : cn);
        cn = __builtin_amdgcn_readfirstlane(cn); mt.cnt[e] = cn; mt.tstart[e] = acc; acc += (cn + 255) >> 8; }
    mt.tstart[NE] = acc; return mt;
}

__global__ void __launch_bounds__(512, 2) mk_fwd(Args args) {
    extern __shared__ __attribute__((aligned(16))) unsigned char lds_raw[];
    LAS unsigned char* lds = (LAS unsigned char*)lds_raw;
    LAS unsigned char* misc = lds + MISC_OFF;
    const int G = gridDim.x, c = blockIdx.x;
    if (threadIdx.x < 4) ((LAS unsigned*)(misc + M_XB))[threadIdx.x] = 0u;
    __syncthreads();
    const int lo = args.ph_lo, hi = args.ph_hi;
    int fdone = 0;
    const bool fill = (lo == 0 && hi == NPHASE && G == 256 && PH_MASK_ALL);
    XcdBarrier bar; bar.bar = (unsigned*)(args.ws + WS_CTL) + CW_BAR; bar.x = 0; bar.st = (volatile LAS unsigned*)(misc + M_XB);
    if (hi - lo > 1) bar = xcd_barrier_post((unsigned*)(args.ws + WS_CTL) + CW_BAR, (volatile LAS unsigned*)(misc + M_XB));
#define IN(k) (((PH_MASK >> ((k) >= 7 && (k) <= 10 ? (k) - 6 : (k))) & 1) && lo <= (k) && (k) < hi)
#define GRID_BAR(k) do { if (IN(k) && IN((k) + 1)) { XcdBarrier b_ = bar; asm volatile("" : "+s"(b_.bar), "+s"(b_.x)); if (fill && (k) < FILL_BARRIERS) xcd_barrier_fill(b_, ap, ws, lds, (volatile LAS unsigned*)(misc + M_XB + 8), (k), c, wid, lane, fdone); else xcd_barrier(b_); if (DBL_BAR) xcd_barrier(b_); } } while (0)
#ifndef REP_MASK
#define REP_MASK 0
#endif
#ifndef DBL_BAR
#define DBL_BAR 0
#endif
#define NREP(k) (((REP_MASK >> (k)) & 1) ? 2 : 1)
#define PHASE_LOCALS ArgP ap = fresh_args(); unsigned char* ws = ap->ws; int tid = threadIdx.x; asm volatile("" : "+v"(tid)); const int lane = tid & 63, wid = __builtin_amdgcn_readfirstlane(tid >> 6); \
    bf16_t* planes = (bf16_t*)(ws + WS_H); bf16_t* xb = (bf16_t*)(ws + WS_XB); float* ssq = (float*)(ws + WS_SSQ); float* xw = ap->out; unsigned* ctl = (unsigned*)(ws + WS_CTL); \
    (void)lane; (void)wid; (void)planes; (void)xb; (void)ssq; (void)xw; (void)ctl;

    if (IN(0)) { PHASE_LOCALS for (int rep = 0; rep < NREP(0); ++rep) { prologue_phase<0>(ap, lds, G, c, tid, wid, lane); if (!fill) prologue_phase<1>(ap, lds, G, c, tid, wid, lane); __syncthreads(); } GRID_BAR(0); }

#pragma unroll
    for (int l = 0; l < 2; ++l) {
        const int pb = 1 + 6 * l;
        if (IN(pb)) { PHASE_LOCALS
            PlainSched S; S.so.init(T / 256, NIN / 256, G, c); S.A = (const char*)xb; S.Bt = (const char*)((bf16_t*)(ws + WS_WIN) + (size_t)l * NIN * D); S.K = D;
            EpiA E{planes, ssq};
            build_rs_table(S, misc, ssq, tid);
            for (int rep = 0; rep < NREP(1); ++rep) pg8::gemm_phase<EpiA, PlainSched, true>(lds, misc, S, E);
            GRID_BAR(pb);
        }
        if (IN(pb + 1)) { PHASE_LOCALS
            const float* cw = (const float*)(ws + WS_CWT) + (size_t)l * D * 32;
#define PHASE_B_BODY \
            for (int sp = c; sp < T / 64; sp += G) conv_span(lds, sp, planes, planes + 5 * PLANE, cw, ap->in[I_CONVB] + l * D, ap->in[I_CLNG] + l * D, ap->in[I_CLNB] + l * D, tid, wid, lane); \
            sgu_phase(lds, c, G, planes + 2 * PLANE, planes + 1 * PLANE, planes + 6 * PLANE, ap->in[I_SLNG] + l * D, ap->in[I_SLNB] + l * D, \
                      (const bf16_t*)(ws + WS_SGW) + (size_t)l * 8 * 128 * 128, ap->in[I_SGB] + l * 8 * 128, tid, wid, lane); \

#if MIX_FUSED && !((REP_MASK >> 2) & 1) && !defined(REP_CONV) && !defined(REP_SGU)
            if (G * 64 == T) mix_fused(lds, c, c, G, planes, planes + 5 * PLANE, cw, ap->in[I_CONVB] + l * D, ap->in[I_CLNG] + l * D, ap->in[I_CLNB] + l * D, planes + 2 * PLANE, planes + 1 * PLANE, planes + 6 * PLANE,
                                       ap->in[I_SLNG] + l * D, ap->in[I_SLNB] + l * D, (const bf16_t*)(ws + WS_SGW) + (size_t)l * 8 * 128 * 128, ap->in[I_SGB] + l * 8 * 128, tid, wid, lane);
            else { PHASE_B_BODY }
#else
            PHASE_B_BODY
#endif
#if (REP_MASK >> 2) & 1
            PHASE_B_BODY
#endif
#undef PHASE_B_BODY
#ifdef REP_CONV
            for (int sp = c; sp < T / 64; sp += G) conv_span(lds, sp, planes, planes + 5 * PLANE, cw, ap->in[I_CONVB] + l * D, ap->in[I_CLNG] + l * D, ap->in[I_CLNB] + l * D, tid, wid, lane);
#endif
#ifdef REP_SGU
            sgu_phase(lds, c, G, planes + 2 * PLANE, planes + 1 * PLANE, planes + 6 * PLANE, ap->in[I_SLNG] + l * D, ap->in[I_SLNB] + l * D, (const bf16_t*)(ws + WS_SGW) + (size_t)l * 8 * 128 * 128, ap->in[I_SGB] + l * 8 * 128, tid, wid, lane);
#endif
            GRID_BAR(pb + 1);
        }
        if (IN(pb + 2)) { PHASE_LOCALS
            PairSched S; S.so.init(T / 256, D / 256, G, c); S.A = (const char*)(planes + 5 * PLANE); S.Bt = (const char*)((bf16_t*)(ws + WS_WCS) + (size_t)l * 2048 * D); S.K = D;
            EpiC E{planes, planes + 3 * PLANE};
            for (int rep = 0; rep < NREP(3); ++rep) pg8::gemm_phase<EpiC, PairSched, true>(lds, misc, S, E);
            GRID_BAR(pb + 2);
        }
        if (IN(pb + 3)) { PHASE_LOCALS
            PlainSched S; S.so.init(T / 256, D / 256, G, c); S.A = (const char*)planes; S.Bt = (const char*)((bf16_t*)(ws + WS_WO) + (size_t)l * D * D); S.K = D;
            if (l == 1) { pg8::Unit u0; if (S.next(0, u0)) { const float* gf = ap->in[I_GFFN] + D; const float* rt = ap->in[I_ROUTER];
                    for (int i = tid; i < 8 * 256; i += 512) { const int e = i >> 8, cg = u0.pn * 256 + (i & 255); ((LAS float*)(misc + M_AUX))[i] = gf[cg] * rt[(size_t)cg * 8 + e]; } }
                __syncthreads(); }
            if (l == 0) {
                EpiD<true, false> E{ap->in[I_X], xb, ssq, nullptr, nullptr, 1.0f};
                if (NREP(4) > 1) { EpiD<true, false> E0{E.xf, planes + 3 * PLANE, (float*)(planes + 5 * PLANE), nullptr, nullptr, 1.0f}; pg8::gemm_phase<EpiD<true, false>, PlainSched, true>(lds, misc, S, E0); }
                pg8::gemm_phase<EpiD<true, false>, PlainSched, true>(lds, misc, S, E);
            } else {
                EpiD<false, true> E{nullptr, xb, ssq, (unsigned char*)(planes + 4 * PLANE), (float*)(planes + 5 * PLANE), 1.0f};
                pg8::gemm_phase<EpiD<false, true>, PlainSched, true>(lds, misc, S, E);
            }
            GRID_BAR(pb + 3);
        }
        if (l == 0) {
            if (IN(5)) { PHASE_LOCALS
                PlainSched S; S.so.init(T / 256, 2 * FFD / 256, G, c); S.A = (const char*)xb; S.Bt = (const char*)(ws + WS_WF13); S.K = D;
                EpiE E{planes, ssq, FFD, FFN_DOWN_FP8};
                build_rs_table(S, misc, ssq, tid);
                for (int rep = 0; rep < NREP(5); ++rep) pg8::gemm_phase<EpiE, PlainSched, true>(lds, misc, S, E);
                GRID_BAR(5);
            }
            if (IN(6)) { PHASE_LOCALS
                PlainSchedT<FFN_DOWN_FP8 != 0> S; S.so.init(T / 256, D / 256, G, c); S.A = (const char*)planes; S.Bt = (const char*)(ws + WS_WF2); S.K = FFN_DOWN_FP8 ? FFD / 2 : FFD;
                EpiD<false, false> E{nullptr, xb, ssq, nullptr, nullptr, FFN_DOWN_FP8 ? 1.0f / W2_SCALE : 1.0f};
                if (NREP(6) > 1) { EpiD<false, false> E0{nullptr, planes + 5 * PLANE, (float*)(planes + 6 * PLANE), nullptr, nullptr, FFN_DOWN_FP8 ? 1.0f / W2_SCALE : 1.0f}; pg8::gemm_phase<EpiD<false, false>, PlainSchedT<FFN_DOWN_FP8 != 0>, true>(lds, misc, S, E0); }
                pg8::gemm_phase<EpiD<false, false>, PlainSchedT<FFN_DOWN_FP8 != 0>, true>(lds, misc, S, E);
                GRID_BAR(6);
            }
        }
    }
    if (IN(11)) { PHASE_LOCALS if (NREP(11) > 1) route_phase(ap, lds, ctl + CW_CNT + 64 * 8, (unsigned char*)planes, G, c, tid, wid, lane);
        route_phase(ap, lds, ctl + CW_CNT, ws + WS_LIST, G, c, tid, wid, lane); GRID_BAR(11); }
    if (IN(12)) { PHASE_LOCALS
        MoeSched<true> S; S.mt = moe_tiles(ctl); S.so.init(S.mt.tstart[NE], 2 * FFE / 256, G, c); S.A = (const char*)(planes + 4 * PLANE); S.Bt = (const char*)(ws + WS_WM13); S.K = D / 2; S.bexp = (size_t)2 * FFE * D; S.rowtok = (const int*)(ws + WS_LIST); S.aux0 = (const float*)(ws + WS_LIST + 1024 * 1024); S.aux1 = nullptr;
        EpiG E{planes, (const float*)(ws + WS_LIST + 1024 * 1024)};
        for (int rep = 0; rep < NREP(12); ++rep) pg8::gemm_phase<EpiG, MoeSched<true>, true>(lds, misc, S, E);
        GRID_BAR(12);
    }
    if (IN(13)) { PHASE_LOCALS
        MoeSched<false> S; S.mt = moe_tiles(ctl); S.so.init(S.mt.tstart[NE], D / 256, G, c); S.A = (const char*)planes; S.Bt = (const char*)(ws + WS_WM2); S.K = FFE / 2; S.bexp = (size_t)D * FFE; S.rowtok = (const int*)(ws + WS_LIST); S.aux0 = (const float*)(ws + WS_LIST); S.aux1 = (const float*)(ws + WS_LIST + 512 * 1024);
        EpiH E{(bf16_t*)(ws + WS_WM13), (const int*)(ws + WS_LIST), (const float*)(ws + WS_LIST + 512 * 1024), S.mt};
        for (int rep = 0; rep < NREP(13); ++rep) pg8::gemm_phase<EpiH, MoeSched<false>, true>(lds, misc, S, E);
        GRID_BAR(13);
    }
    if (IN(14)) { PHASE_LOCALS
        const bf16_t* slots = (const bf16_t*)(ws + WS_WM13); const float* gfin = ap->in[I_GFINAL];
        f32x4 gv[4];
#pragma unroll
        for (int j = 0; j < 4; ++j) gv[j] = *((const f32x4*)gfin + lane + 64 * j);
        for (int rep = NREP(14) - 1; rep >= 0; --rep)
        for (int m = c * 8 + wid; m < T; m += G * 8) { const u32x2* xr = (const u32x2*)(xb + (size_t)m * D) + lane; f32x4* xo = (f32x4*)((rep ? (float*)planes : xw) + (size_t)m * D) + lane;
            const u32x2* s0 = (const u32x2*)(slots + (size_t)(2 * m) * D) + lane; const u32x2* s1 = (const u32x2*)(slots + (size_t)(2 * m + 1) * D) + lane;
            f32x4 v[4]; float s = 0.f;
#pragma unroll
            for (int j = 0; j < 4; ++j) { const u32x2 a = s0[64 * j], b = s1[64 * j], xv = xr[64 * j]; v[j] = (f32x4){bf_lo(xv.x), bf_hi(xv.x), bf_lo(xv.y), bf_hi(xv.y)} + (f32x4){bf_lo(a.x), bf_hi(a.x), bf_lo(a.y), bf_hi(a.y)} + (f32x4){bf_lo(b.x), bf_hi(b.x), bf_lo(b.y), bf_hi(b.y)};
                s += (v[j][0] * v[j][0] + v[j][1] * v[j][1]) + (v[j][2] * v[j][2] + v[j][3] * v[j][3]); }
            const float rs = __builtin_amdgcn_rsqf(wave_sum(s) * (1.0f / D) + EPS);
#pragma unroll
            for (int j = 0; j < 4; ++j) xo[64 * j] = v[j] * rs * gv[j]; }
    }
#undef IN
#undef GRID_BAR
#undef PHASE_LOCALS
}

extern "C" void kernel_launch(void* const* d_in, const int* in_sizes, int n_in, void* d_out, int out_size, void* d_ws, size_t ws_size, hipStream_t stream) {
    static int grid = 0;
    if (grid == 0) {
        if (n_in != 23 || in_sizes[0] != T * D || out_size != T * D || ws_size < WS_END) { fprintf(stderr, "kernel_launch: unexpected shapes (n_in %d, in0 %d, out %d, ws %zu < %zu); nothing launched\n", n_in, n_in > 0 ? in_sizes[0] : -1, out_size, ws_size, (size_t)WS_END); grid = -1; return; }
        int dev = 0, cus = 0, per_cu = 0;
        if (hipGetDevice(&dev) != hipSuccess || hipDeviceGetAttribute(&cus, hipDeviceAttributeMultiprocessorCount, dev) != hipSuccess) { grid = -1; return; }
        if (hipFuncSetAttribute((const void*)mk_fwd, hipFuncAttributeMaxDynamicSharedMemorySize, LDS_BYTES) != hipSuccess) { fprintf(stderr, "kernel_launch: hipFuncSetAttribute failed\n"); grid = -1; return; }
        if (hipOccupancyMaxActiveBlocksPerMultiprocessor(&per_cu, (const void*)mk_fwd, 512, LDS_BYTES) != hipSuccess || per_cu < 1) fprintf(stderr, "kernel_launch: note: occupancy query reports %d\n", per_cu);
        (void)hipGetLastError();
        grid = cus;
    }
    if (grid < 0) return;
    if (hipMemsetAsync((char*)d_ws + WS_CTL, 0, CTL_ZERO_BYTES, stream) != hipSuccess) return;
    Args a{};
    for (int i = 0; i < 23; ++i) a.in[i] = (const float*)d_in[i];
    a.out = (float*)d_out; a.ws = (unsigned char*)d_ws;
#if MK_N_LAUNCHES == 1
    a.ph_lo = 0; a.ph_hi = NPHASE;
    hipLaunchKernelGGL(mk_fwd, dim3(grid), dim3(512), LDS_BYTES, stream, a);
#else
    for (int p = 0; p < NPHASE; ++p) { a.ph_lo = p; a.ph_hi = p + 1; hipLaunchKernelGGL(mk_fwd, dim3(grid), dim3(512), LDS_BYTES, stream, a); }
#endif
}
```
